# Optimizing an MI355X kernel written in HIP

```python
import jax, jax.numpy as jnp
from jax import lax
import numpy as np

D_MODEL = 1024
BATCH = 4
SEQ = 8192
DEPTH = 4

PLE_DIM = 256
N_BRANCH = 4
BRANCH_WIDTH = 256
HEAD_DIM = 64
N_HEADS = BRANCH_WIDTH // HEAD_DIM
CONV_WIDTH = 3
ATTN_BLOCK = 128
GLA_CHUNK = 64
SPATIAL_CHUNK = 128
EPS = 1e-6
MASK_VALUE = -1e30
IN_COLS = 15 * BRANCH_WIDTH + N_HEADS + N_BRANCH * D_MODEL

kernel_name = "hybrid_conv_fox_hgrn2_gmlp_gated_merge"


def _split_points():
    W = BRANCH_WIDTH
    sizes = [W] * 4 + [W] * 4 + [N_HEADS] + [W] * 4 + [W] * 3 + [N_BRANCH * D_MODEL]
    return [int(s) for s in np.cumsum(sizes)[:-1]]


def rms_norm(x, g):
    xf = x.astype(jnp.float32)
    return xf * lax.rsqrt(jnp.mean(xf * xf, axis=-1, keepdims=True) + EPS) * g.astype(jnp.float32)


def group_rms_norm(x, g):
    Bn, S, W = x.shape
    xg = x.astype(jnp.float32).reshape(Bn, S, N_HEADS, HEAD_DIM)
    xg = xg * lax.rsqrt(jnp.mean(xg * xg, axis=-1, keepdims=True) + EPS)
    return (xg * g.astype(jnp.float32).reshape(N_HEADS, HEAD_DIM)).reshape(Bn, S, W)


def short_conv_mixer(x_in, b, c, w, bias):
    S = x_in.shape[1]
    z = c.astype(jnp.float32) * x_in.astype(jnp.float32)
    zp = jnp.pad(z, ((0, 0), (CONV_WIDTH - 1, 0), (0, 0)))
    wf = w.astype(jnp.float32)
    y = zp[:, 0:S] * wf[0]
    for tap in range(1, CONV_WIDTH):
        y = y + zp[:, tap:tap + S] * wf[tap]
    return b.astype(jnp.float32) * (y + bias.astype(jnp.float32))


def forgetting_attention(q, k, v, f_logit, gq, gk):
    Bn, S, _ = q.shape
    f32 = jnp.float32

    def heads(t):
        return t.astype(f32).reshape(Bn, S, N_HEADS, HEAD_DIM).transpose(0, 2, 1, 3)

    qh = rms_norm(heads(q), gq)
    kh = rms_norm(heads(k), gk)
    vh = heads(v)
    cum = jnp.cumsum(jax.nn.log_sigmoid(f_logit.astype(f32)).transpose(0, 2, 1), axis=-1)
    nb = S // ATTN_BLOCK
    qb = qh.reshape(Bn, N_HEADS, nb, ATTN_BLOCK, HEAD_DIM).transpose(2, 0, 1, 3, 4)
    cb = cum.reshape(Bn, N_HEADS, nb, ATTN_BLOCK).transpose(2, 0, 1, 3)
    kpos = jnp.arange(S)
    scale = HEAD_DIM ** -0.5

    def block(args):
        qi, ci, bi = args
        logits = jnp.einsum('bhqd,bhkd->bhqk', qi, kh) * scale + (ci[..., None] - cum[:, :, None, :])
        qpos = bi * ATTN_BLOCK + jnp.arange(ATTN_BLOCK)
        mask = qpos[:, None] >= kpos[None, :]
        probs = jax.nn.softmax(jnp.where(mask, logits, MASK_VALUE), axis=-1)
        return jnp.einsum('bhqk,bhkd->bhqd', probs, vh)

    o = lax.map(block, (qb, cb, jnp.arange(nb)))
    return o.transpose(1, 0, 3, 2, 4).reshape(Bn, S, N_HEADS * HEAD_DIM)


def hgrn2_recurrence(q, f_logit, i_in, lb, gain):
    Bn, S, W = q.shape
    f32 = jnp.float32
    qf = jax.nn.silu(q.astype(f32))
    fl = f_logit.astype(f32)
    lbf = lb.astype(f32)
    log_g = jnp.log(lbf + (1.0 - lbf) * jax.nn.sigmoid(fl))
    kf = (1.0 - lbf) * jax.nn.sigmoid(-fl)
    vf = i_in.astype(f32)
    nc = S // GLA_CHUNK

    def chunks(t):
        return t.reshape(Bn, nc, GLA_CHUNK, N_HEADS, HEAD_DIM).transpose(1, 0, 3, 2, 4)

    causal = jnp.tril(jnp.ones((GLA_CHUNK, GLA_CHUNK), dtype=bool))[:, :, None]

    def step(state, inp):
        qc, kc, vc, gc = inp
        b = jnp.cumsum(gc, axis=2)
        o_inter = jnp.einsum('bhtk,bhkv->bhtv', qc * jnp.exp(b), state)
        diff = b[:, :, :, None, :] - b[:, :, None, :, :]
        decay = jnp.where(causal, jnp.exp(jnp.where(causal, diff, 0.0)), 0.0)
        scores = jnp.einsum('bhtk,bhsk,bhtsk->bhts', qc, kc, decay)
        o_intra = jnp.einsum('bhts,bhsv->bhtv', scores, vc)
        b_last = b[:, :, -1]
        new_state = jnp.exp(b_last)[..., None] * state + jnp.einsum(
            'bhsk,bhsv->bhkv', kc * jnp.exp(b_last[:, :, None] - b), vc)
        return new_state, o_inter + o_intra

    state0 = jnp.zeros((Bn, N_HEADS, HEAD_DIM, HEAD_DIM), f32)
    _, o = lax.scan(step, state0, (chunks(qf), chunks(kf), chunks(vf), chunks(log_g)))
    o = o.transpose(1, 0, 3, 2, 4).reshape(Bn, S, W)
    return group_rms_norm(o, gain)


def spatial_gating_mixer(u, v, gv, w_s, b_s):
    Bn, S, W = u.shape
    vn = group_rms_norm(v, gv).reshape(Bn, S // SPATIAL_CHUNK, SPATIAL_CHUNK, N_HEADS, HEAD_DIM)
    causal = jnp.tril(jnp.ones((SPATIAL_CHUNK, SPATIAL_CHUNK), dtype=jnp.float32))
    w = w_s.astype(jnp.float32) * causal
    s = jnp.einsum('gts,bnsgc->bntgc', w, vn) + b_s.astype(jnp.float32).T[None, None, :, :, None]
    return u.astype(jnp.float32) * s.reshape(Bn, S, W)


def setup_inputs(seed: int = 0) -> dict:
    key = jax.random.key(seed)
    ks = jax.random.split(key, 24)
    W = BRANCH_WIDTH
    n = jax.random.normal
    f32 = jnp.float32
    return {
        "x": n(ks[0], (BATCH, SEQ, D_MODEL), f32),
        "p": n(ks[1], (DEPTH, BATCH, SEQ, PLE_DIM), f32),
        "norm_mix": 1.0 + 0.02 * n(ks[2], (DEPTH, D_MODEL), f32),
        "w_in": n(ks[3], (DEPTH, D_MODEL, IN_COLS), f32) * D_MODEL ** -0.5,
        "conv_w": n(ks[4], (DEPTH, CONV_WIDTH, W), f32) * CONV_WIDTH ** -0.5,
        "conv_b": 0.02 * n(ks[5], (DEPTH, W), f32),
        "fgate_bias": jnp.linspace(1.0, 4.0, N_HEADS, dtype=f32) + 0.1 * n(ks[6], (DEPTH, N_HEADS), f32),
        "q_norm": 1.0 + 0.02 * n(ks[7], (DEPTH, HEAD_DIM), f32),
        "k_norm": 1.0 + 0.02 * n(ks[8], (DEPTH, HEAD_DIM), f32),
        "lb_logits": 0.5 * n(ks[9], (DEPTH, W), f32),
        "hgrn_norm": 1.0 + 0.02 * n(ks[10], (DEPTH, W), f32),
        "sgu_norm": 1.0 + 0.02 * n(ks[11], (DEPTH, W), f32),
        "spatial_w": 0.5 * n(ks[12], (DEPTH, N_HEADS, SPATIAL_CHUNK, SPATIAL_CHUNK), f32) * SPATIAL_CHUNK ** -0.5,
        "spatial_b": 1.0 + 0.02 * n(ks[13], (DEPTH, N_HEADS, SPATIAL_CHUNK), f32),
        "w_up": n(ks[14], (DEPTH, N_BRANCH, W, D_MODEL), f32) * W ** -0.5,
        "merge_b": 0.02 * n(ks[15], (DEPTH, N_BRANCH, D_MODEL), f32),
        "w_o": n(ks[16], (DEPTH, D_MODEL, D_MODEL), f32) * (0.5 * D_MODEL ** -0.5),
        "norm_ple": 1.0 + 0.02 * n(ks[17], (DEPTH, D_MODEL), f32),
        "w_ple_gate": n(ks[18], (DEPTH, D_MODEL, D_MODEL), f32) * D_MODEL ** -0.5,
        "w_ple_proj": n(ks[19], (DEPTH, PLE_DIM, D_MODEL), f32) * (0.5 * PLE_DIM ** -0.5),
    }


def reference(x, p, norm_mix, w_in, conv_w, conv_b, fgate_bias, q_norm, k_norm, lb_logits,
              hgrn_norm, sgu_norm, spatial_w, spatial_b, w_up, merge_b, w_o, norm_ple,
              w_ple_gate, w_ple_proj):
    dt = x.dtype
    Bn, S, _ = x.shape
    splits = _split_points()
    lb_p = jax.nn.softmax(lb_logits.astype(jnp.float32), axis=0)
    lower_bounds = jnp.clip(jnp.cumsum(lb_p, axis=0) - lb_p[0], 0.0, 1.0)
    for li in range(DEPTH):
        h = rms_norm(x, norm_mix[li]).astype(dt)
        z = h @ w_in[li]
        (a_x, a_b, a_c, a_g,
         b_q, b_k, b_v, b_g, b_f,
         c_q, c_f, c_i, c_g,
         d_u, d_v, d_g, m_logits) = jnp.split(z, splits, axis=-1)

        y_a = short_conv_mixer(a_x, a_b, a_c, conv_w[li], conv_b[li]).astype(dt) * jax.nn.silu(a_g)
        y_b = forgetting_attention(b_q, b_k, b_v, b_f + fgate_bias[li], q_norm[li], k_norm[li]).astype(dt) * jax.nn.silu(b_g)
        y_c = hgrn2_recurrence(c_q, c_f, c_i, lower_bounds[li], hgrn_norm[li]).astype(dt) * jax.nn.silu(c_g)
        y_d = spatial_gating_mixer(d_u, d_v, sgu_norm[li], spatial_w[li], spatial_b[li]).astype(dt) * jax.nn.silu(d_g)

        branches = (y_a, y_b, y_c, y_d)
        gate_logits = m_logits.reshape(Bn, S, N_BRANCH, D_MODEL)
        merged = jax.nn.sigmoid(gate_logits[:, :, 0] + merge_b[li, 0]) * (branches[0] @ w_up[li, 0])
        for bi in range(1, N_BRANCH):
            merged = merged + jax.nn.sigmoid(gate_logits[:, :, bi] + merge_b[li, bi]) * (branches[bi] @ w_up[li, bi])
        x = x + merged @ w_o[li]

        hp = rms_norm(x, norm_ple[li]).astype(dt)
        x = x + jax.nn.sigmoid(hp @ w_ple_gate[li]) * (p[li] @ w_ple_proj[li])
    return x
```

```cpp
#include <hip/hip_runtime.h>
#include <hip/hip_cooperative_groups.h>
#include <cstdio>
#include <cstdint>
namespace cg = cooperative_groups;

#define LAS __attribute__((address_space(3)))
typedef unsigned short bf16_t;
typedef short bf16x8 __attribute__((ext_vector_type(8)));
typedef float f32x4 __attribute__((ext_vector_type(4)));
typedef float f32x16 __attribute__((ext_vector_type(16)));
typedef unsigned u32x4 __attribute__((ext_vector_type(4)));
typedef unsigned u32x2 __attribute__((ext_vector_type(2)));

constexpr int MTOK = 32768, DM = 1024, SEQ = 8192, NBAT = 4, BW = 256, NH = 4, HD = 64, DEPTH = 4, PLE = 256, INC = 7940;
constexpr int ZLD = 3840;
constexpr int Z_AX = 0, Z_AB = 256, Z_AC = 512, Z_AG = 768, Z_BQ = 1024, Z_BK = 1280, Z_BV = 1536, Z_BG = 1792,
              Z_CQ = 2048, Z_CF = 2304, Z_CI = 2560, Z_CG = 2816, Z_DU = 3072, Z_DV = 3328, Z_DG = 3584;
constexpr float EPS = 1e-6f, LOG2E = 1.4426950408889634f;
constexpr int NTHR = 512, NWAVES = 8;
constexpr int LDS_BYTES = 147456;

constexpr size_t MiB = 1u << 20;
constexpr size_t WS_WIN = 1 * MiB;
constexpr size_t WS_WUP = 17 * MiB;
constexpr size_t WS_WO = 25 * MiB;
constexpr size_t WS_WPG = 33 * MiB;
constexpr size_t WS_WPP = 41 * MiB;
constexpr size_t WS_PBF = 43 * MiB;
constexpr size_t WS_SSA = 59 * MiB;
constexpr size_t WS_SSB = 61 * MiB;
constexpr size_t WS_FLOG = 63 * MiB;
constexpr size_t WS_CUM = 63 * MiB + 512 * 1024;
constexpr size_t WS_BTOT = 64 * MiB;
constexpr size_t WS_DVEC = 64 * MiB + 512 * 1024;
constexpr size_t WS_VT = 66 * MiB;
constexpr size_t WS_U = 82 * MiB;
constexpr size_t WS_BUFH = 114 * MiB;
constexpr size_t WS_BUFY = 178 * MiB;
constexpr size_t WS_ZG = 242 * MiB;
constexpr size_t WS_END = 498 * MiB;

__device__ __forceinline__ unsigned f2bf(float f) { unsigned u = __builtin_bit_cast(unsigned, f); return (u + 0x7fffu + ((u >> 16) & 1u)) >> 16; }
typedef float f32x2 __attribute__((ext_vector_type(2)));
typedef __bf16 bf16x2_t __attribute__((ext_vector_type(2)));
__device__ __forceinline__ unsigned pk2(float lo, float hi) { const f32x2 v = {lo, hi}; const bf16x2_t b = __builtin_convertvector(v, bf16x2_t); return __builtin_bit_cast(unsigned, b); }
__device__ __forceinline__ float bflo(unsigned u) { return __builtin_bit_cast(float, u << 16); }
__device__ __forceinline__ float bfhi(unsigned u) { return __builtin_bit_cast(float, u & 0xffff0000u); }
__device__ __forceinline__ void unpack8(u32x4 w, f32x4& a, f32x4& b) { a = (f32x4){bflo(w.x), bfhi(w.x), bflo(w.y), bfhi(w.y)}; b = (f32x4){bflo(w.z), bfhi(w.z), bflo(w.w), bfhi(w.w)}; }
__device__ __forceinline__ u32x4 pack8(f32x4 a, f32x4 b) { u32x4 w; w.x = pk2(a[0], a[1]); w.y = pk2(a[2], a[3]); w.z = pk2(b[0], b[1]); w.w = pk2(b[2], b[3]); return w; }
#define DPP_ADD(v, ctrl) ((v) + __builtin_bit_cast(float, __builtin_amdgcn_update_dpp(0, __builtin_bit_cast(int, (v)), (ctrl), 0xF, 0xF, true)))
__device__ __forceinline__ int opq(int v) { asm volatile("" : "+v"(v)); return v; }
__device__ __forceinline__ float sigm(float x) { return __builtin_amdgcn_rcpf(1.f + __expf(-x)); }
__device__ __forceinline__ float silu(float x) { return x * __builtin_amdgcn_rcpf(1.f + __expf(-x)); }
__device__ __forceinline__ f32x4 silu4(f32x4 v) { return (f32x4){silu(v[0]), silu(v[1]), silu(v[2]), silu(v[3])}; }

namespace pg8 {
constexpr int BM = 256, BK = 64, HALF = 128, HTB = HALF * BK * 2, STAGE_BYTES = 8 * HTB, NXCD = 8, WGM = 8;
__host__ __device__ __forceinline__ int lds_byte(int r, int c) { const int st = (r >> 4) * 2 + (c >> 5), rr = r & 15, cc = c & 31, ob = rr * 64 + cc * 2; return st * 1024 + (ob ^ (((ob >> 9) & 1) << 5)); }
__host__ __device__ __forceinline__ void stage_rc(int b, int& R, int& C) { const int st = b / 1024, sb = b % 1024, swz = sb ^ (((sb >> 9) & 1) << 5); R = (st >> 1) * 16 + swz / 64; C = (st & 1) * 32 + (swz % 64) / 2; }
__host__ __device__ __forceinline__ int perm32(int rho) { const int n = rho >> 4, i = rho & 15; return 8 * (i >> 2) + 4 * n + (i & 3); }

struct Unit { int pm, pn, sub; };
struct Gemm { const bf16_t* A; const bf16_t* Bt; int lda, ldb, K; size_t subA, subB; };

struct StaticOrder {
    int nM, nN, nwg, G, c, pm0;
    __device__ void init(int M, int N, int G_, int c_, int pm0_ = 0) { nM = M / BM; nN = N / BM; nwg = nM * nN; G = G_; c = c_; pm0 = pm0_; }
    __device__ bool next(int i, Unit& u) const {
        const long L = (long)i * G + c; if (L >= nwg) return false;
        int wgid = (int)L; { const int q = nwg / NXCD, r = nwg % NXCD, xcd = wgid % NXCD, off = wgid / NXCD; wgid = (xcd < r ? xcd * (q + 1) : r * (q + 1) + (xcd - r) * q) + off; }
        const int nig = WGM * nN, gid = wgid / nig, fm = gid * WGM, gsz = (nM - fm) < WGM ? (nM - fm) : WGM;
        u.pm = pm0 + fm + ((wgid % nig) % gsz); u.pn = (wgid % nig) / gsz; u.sub = 0; return true;
    }
};
struct SubOrder {
    StaticOrder so;
    __device__ bool next(int i, Unit& u) const { if (!so.next(i >> 2, u)) return false; u.sub = i & 3; return true; }
};

template <class Epi, class Sched>
__device__ __forceinline__ void gemm_phase(LAS unsigned char* lds, const Gemm g, const Sched& S, const Epi& E) {
    int tid_ = threadIdx.x; asm volatile("" : "+v"(tid_));
    const int tid = tid_, wid = __builtin_amdgcn_readfirstlane(tid >> 6), lane = tid & 63, wr = wid >> 2, wc = wid & 3, fr = lane & 15, fq = lane >> 4;
    const int K = g.K; int nt_ = K / BK; asm volatile("" : "+s"(nt_)); const int nt = nt_;
    unsigned voffA[2], voffB[2];
#pragma unroll
    for (int i = 0; i < 2; ++i) { int R, C; stage_rc(tid * 16 + i * 8192, R, C); const int Rb = (R & ~31) + perm32(R & 31);
        voffA[i] = (unsigned)(R * g.lda + C) * 2u; voffB[i] = (unsigned)(Rb * g.ldb + C) * 2u; }
    const size_t kstep = (size_t)(BK * 2);
    const size_t hstepA = (size_t)HALF * g.lda * 2, hstepB = (size_t)HALF * g.ldb * 2;
    const size_t tstepA = 2 * hstepA, tstepB = 2 * hstepB;
    const unsigned ldsw = (unsigned)wid * 1024u;
    const int aoff = lds_byte(wr * 64 + fr, fq * 8), boff = lds_byte(wc * 32 + fr, fq * 8);
#define PG8_SA(b, h) (((b) * 2 + (h)) * HTB)
#define PG8_SB(b, h) ((4 + (b) * 2 + (h)) * HTB)
#define PG8_STAGE(bufoff, gbase, voff) do { _Pragma("unroll") for (int _i = 0; _i < 2; ++_i) \
        __builtin_amdgcn_global_load_lds((const unsigned*)((const char*)(gbase) + (voff)[_i]), (LAS unsigned*)(lds + (bufoff) + ldsw + _i * 8192), 16, 0, 0); } while (0)
#define PG8_LDA(dst, b, h) do { _Pragma("unroll") for (int m = 0; m < 4; ++m) _Pragma("unroll") for (int k = 0; k < 2; ++k) dst[m][k] = *(const LAS bf16x8*)(lds + PG8_SA(b, h) + aoff + m * 2048 + k * 1024); } while (0)
#define PG8_LDB(dst, b, h) do { _Pragma("unroll") for (int n = 0; n < 2; ++n) _Pragma("unroll") for (int k = 0; k < 2; ++k) dst[n][k] = *(const LAS bf16x8*)(lds + PG8_SB(b, h) + boff + n * 2048 + k * 1024); } while (0)
#define PG8_MMA(ai, bj, At, Bt) do { __builtin_amdgcn_s_setprio(1); _Pragma("unroll") for (int m = 0; m < 4; ++m) _Pragma("unroll") for (int n = 0; n < 2; ++n) _Pragma("unroll") for (int k = 0; k < 2; ++k) \
        acc[ai][bj][m][n] = __builtin_amdgcn_mfma_f32_16x16x32_bf16(Bt[n][k], At[m][k], acc[ai][bj][m][n], 0, 0, 0); __builtin_amdgcn_s_setprio(0); } while (0)
#define PG8_WAIT_V(n) asm volatile("s_waitcnt vmcnt(" #n ")" ::: "memory")
#define PG8_WAIT_L(n) asm volatile("s_waitcnt lgkmcnt(" #n ")" ::: "memory")
#define PG8_BAR __builtin_amdgcn_s_barrier()
#define PG8_SCHED __builtin_amdgcn_sched_barrier(0)
    Unit cur, nxt; int ui = 0;
    if (!S.next(0, cur)) return;
    f32x4 acc[2][2][4][2];
#pragma unroll
    for (int a = 0; a < 2; ++a)
#pragma unroll
        for (int b = 0; b < 2; ++b)
#pragma unroll
            for (int m = 0; m < 4; ++m)
#pragma unroll
                for (int n = 0; n < 2; ++n) acc[a][b][m][n] = (f32x4){0.f, 0.f, 0.f, 0.f};
    bf16x8 At[4][2], B0[2][2], B1[2][2];
    const char* cA = (const char*)g.A + (size_t)cur.pm * tstepA + (size_t)cur.sub * g.subA;
    const char* cB = (const char*)g.Bt + (size_t)cur.pn * tstepB + (size_t)cur.sub * g.subB;
    PG8_STAGE(PG8_SB(0, 0), cB, voffB); PG8_STAGE(PG8_SB(0, 1), cB + hstepB, voffB); PG8_STAGE(PG8_SA(0, 0), cA, voffA); PG8_STAGE(PG8_SA(0, 1), cA + hstepA, voffA);
    if (wr == 1) PG8_BAR;
    PG8_WAIT_V(2); PG8_BAR;
    PG8_STAGE(PG8_SB(1, 0), cB + kstep, voffB); PG8_STAGE(PG8_SA(1, 0), cA + kstep, voffA); PG8_STAGE(PG8_SB(1, 1), cB + hstepB + kstep, voffB);
    PG8_WAIT_V(6); PG8_BAR;
    for (;;) {
        const bool has_next = S.next(ui + 1, nxt);
        const char* nA = has_next ? (const char*)g.A + (size_t)nxt.pm * tstepA + (size_t)nxt.sub * g.subA : cA;
        const char* nB = has_next ? (const char*)g.Bt + (size_t)nxt.pn * tstepB + (size_t)nxt.sub * g.subB : cB;
        for (int t = 0; t < nt; t += 2) {
            const bool last = (t == nt - 2);
            const char* a1 = cA + (size_t)(t + 1) * kstep;
            const char* a2 = last ? nA : cA + (size_t)(t + 2) * kstep; const char* b2 = last ? nB : cB + (size_t)(t + 2) * kstep;
            const char* a3 = a2 + kstep; const char* b3 = b2 + kstep;
            PG8_LDB(B0, 0, 0); PG8_LDB(B1, 0, 1); PG8_SCHED; PG8_LDA(At, 0, 0); PG8_STAGE(PG8_SA(1, 1), a1 + hstepA, voffA);
            PG8_WAIT_V(8); PG8_WAIT_L(0); PG8_BAR; PG8_MMA(0, 0, At, B0); PG8_MMA(0, 1, At, B1); PG8_BAR; PG8_SCHED;
            PG8_LDA(At, 0, 1); PG8_STAGE(PG8_SB(0, 0), b2, voffB); PG8_STAGE(PG8_SB(0, 1), b2 + hstepB, voffB); PG8_STAGE(PG8_SA(0, 0), a2, voffA);
            PG8_WAIT_V(8); PG8_WAIT_L(0); PG8_BAR; PG8_MMA(1, 0, At, B0); PG8_MMA(1, 1, At, B1); PG8_BAR; PG8_SCHED;
            PG8_LDB(B0, 1, 0); PG8_LDB(B1, 1, 1); PG8_SCHED; PG8_LDA(At, 1, 0); PG8_STAGE(PG8_SA(0, 1), a2 + hstepA, voffA);
            PG8_WAIT_V(8); PG8_WAIT_L(0); PG8_BAR; PG8_MMA(0, 0, At, B0); PG8_MMA(0, 1, At, B1); PG8_BAR; PG8_SCHED;
            PG8_LDA(At, 1, 1); PG8_STAGE(PG8_SB(1, 0), b3, voffB); PG8_STAGE(PG8_SB(1, 1), b3 + hstepB, voffB); PG8_STAGE(PG8_SA(1, 0), a3, voffA);
            PG8_WAIT_V(8); PG8_WAIT_L(0); PG8_BAR; PG8_MMA(1, 0, At, B0); PG8_MMA(1, 1, At, B1); PG8_BAR; PG8_SCHED;
        }
        if (wr == 0) PG8_BAR;
        E(acc, cur, wr, wc, fr, fq);
        if (!has_next) break;
        if (!(Epi::SUBACC && nxt.sub != 0)) {
#pragma unroll
            for (int a = 0; a < 2; ++a)
#pragma unroll
                for (int b = 0; b < 2; ++b)
#pragma unroll
                    for (int m = 0; m < 4; ++m)
#pragma unroll
                        for (int n = 0; n < 2; ++n) acc[a][b][m][n] = (f32x4){0.f, 0.f, 0.f, 0.f};
        }
        cur = nxt; cA = nA; cB = nB; ++ui;
        if (wr == 1) PG8_BAR;
    }
    PG8_WAIT_V(0);
    PG8_BAR;
#undef PG8_SA
#undef PG8_SB
#undef PG8_STAGE
#undef PG8_LDA
#undef PG8_LDB
#undef PG8_MMA
#undef PG8_WAIT_V
#undef PG8_WAIT_L
#undef PG8_BAR
#undef PG8_SCHED
}

typedef f32x4 Acc[2][2][4][2];
__device__ __forceinline__ void row_rstd(const float* part, int row0, int fq, float (&rs)[2][4]) {
#pragma unroll
    for (int ai = 0; ai < 2; ++ai)
#pragma unroll
        for (int m = 0; m < 4; ++m) { const int r = row0 + ai * HALF + m * 16; float s = 0.f;
#pragma unroll
            for (int j = 0; j < 4; ++j) s += part[(size_t)(4 * fq + j) * MTOK + r];
            s += __shfl_xor(s, 16); s += __shfl_xor(s, 32);
            rs[ai][m] = 1.0f / sqrtf(s * (1.0f / DM) + EPS); }
}

template <class Sched>
__device__ __forceinline__ void stage_rstd(const float* part, const Sched& S, unsigned char* lds_raw) {
    float* tab = (float*)(lds_raw + 131072 + 1024); int* tags = (int*)(lds_raw + 131072 + 512);
    Unit u; int last = -1, slot = 0; const int tid = opq(threadIdx.x);
    for (int i = 0; slot < 4 && S.next(i, u); ++i) { if (u.pm == last) continue; last = u.pm;
        if (tid < 256) { const int r = u.pm * BM + tid; float s = 0.f;
#pragma unroll
            for (int j = 0; j < 16; ++j) s += part[(size_t)j * MTOK + r];
            tab[slot * 256 + tid] = 1.0f / sqrtf(s * (1.0f / DM) + EPS); }
        if (tid == 0) tags[slot] = u.pm;
        ++slot; }
    for (; slot < 4; ++slot) if (tid == 0) tags[slot] = -1;
    __syncthreads();
}
__device__ __forceinline__ void row_rstd_lds(const float* part, const unsigned char* lds_raw, int pm, int wr, int fr, int fq, float (&rs)[2][4]) {
    const float* tab = (const float*)(lds_raw + 131072 + 1024); const int* tags = (const int*)(lds_raw + 131072 + 512);
    int slot = -1;
#pragma unroll
    for (int k = 0; k < 4; ++k) if (tags[k] == pm) slot = k;
    if (slot < 0) slot = 0;
#pragma unroll
    for (int ai = 0; ai < 2; ++ai)
#pragma unroll
        for (int m = 0; m < 4; ++m) rs[ai][m] = tab[slot * 256 + ai * HALF + wr * 64 + m * 16 + fr];
}

struct EpiZ {
    static constexpr bool SUBACC = false;
    bf16_t* Z; float* flog; const float* part; const unsigned char* ldsr;
    __device__ __forceinline__ void operator()(const Acc& acc, const Unit& u, int wr, int wc, int fr, int fq) const {
        const int row0 = u.pm * BM + wr * 64 + fr; float rs[2][4]; row_rstd_lds(part, ldsr, u.pm, wr, fr, fq, rs);
        if (u.pn < 15) {
            const int col0 = u.pn * BM + wc * 32 + 8 * fq;
#pragma unroll
            for (int ai = 0; ai < 2; ++ai)
#pragma unroll
                for (int m = 0; m < 4; ++m) { bf16_t* rowp = Z + (size_t)(row0 + ai * HALF + m * 16) * ZLD + col0; const float s = rs[ai][m];
#pragma unroll
                    for (int bj = 0; bj < 2; ++bj) *(u32x4*)(rowp + bj * HALF) = pack8(acc[ai][bj][m][0] * s, acc[ai][bj][m][1] * s); }
        } else if (wc == 0 && fq == 0) {
#pragma unroll
            for (int ai = 0; ai < 2; ++ai)
#pragma unroll
                for (int m = 0; m < 4; ++m) *(f32x4*)(flog + (size_t)(row0 + ai * HALF + m * 16) * 4) = acc[ai][0][m][0] * rs[ai][m];
        }
    }
};
struct EpiGate {
    static constexpr bool SUBACC = false;
    bf16_t* G; const float* part; const float* mb; const unsigned char* ldsr;
    __device__ __forceinline__ void operator()(const Acc& acc, const Unit& u, int wr, int wc, int fr, int fq) const {
        const int row0 = u.pm * BM + wr * 64 + fr; float rs[2][4]; row_rstd_lds(part, ldsr, u.pm, wr, fr, fq, rs);
        const int col0 = u.pn * BM + wc * 32 + 8 * fq;
        f32x4 bv[2][2];
#pragma unroll
        for (int bj = 0; bj < 2; ++bj)
#pragma unroll
            for (int n = 0; n < 2; ++n) bv[bj][n] = *(const f32x4*)(mb + col0 + bj * HALF + 4 * n);
#pragma unroll
        for (int ai = 0; ai < 2; ++ai)
#pragma unroll
            for (int m = 0; m < 4; ++m) { bf16_t* rowp = G + (size_t)(row0 + ai * HALF + m * 16) * 4096 + col0; const float s = rs[ai][m];
#pragma unroll
                for (int bj = 0; bj < 2; ++bj) { f32x4 v0 = acc[ai][bj][m][0] * s + bv[bj][0], v1 = acc[ai][bj][m][1] * s + bv[bj][1];
#pragma unroll
                    for (int e = 0; e < 4; ++e) { v0[e] = fmaxf(sigm(v0[e]), 9.3132257e-10f); v1[e] = fmaxf(sigm(v1[e]), 9.3132257e-10f); }
                    *(u32x4*)(rowp + bj * HALF) = pack8(v0, v1); } }
    }
};
struct EpiMerge {
    static constexpr bool SUBACC = true;
    const bf16_t* G; bf16_t* Mg;
    __device__ __forceinline__ void operator()(Acc& acc, const Unit& u, int wr, int wc, int fr, int fq) const {
        const int row0 = u.pm * BM + wr * 64 + fr, col0 = u.pn * BM + wc * 32 + 8 * fq, b = u.sub;
#pragma unroll
        for (int ai = 0; ai < 2; ++ai)
#pragma unroll
            for (int m = 0; m < 4; ++m) { const size_t r = (size_t)(row0 + ai * HALF + m * 16);
#pragma unroll
                for (int bj = 0; bj < 2; ++bj) {
                    const bf16_t* gp = G + r * 4096 + b * 1024 + col0 + bj * HALF;
                    f32x4 g0, g1; unpack8(*(const u32x4*)gp, g0, g1);
                    if (b < 3) { f32x4 h0, h1; unpack8(*(const u32x4*)(gp + 1024), h0, h1);
#pragma unroll
                        for (int e = 0; e < 4; ++e) { g0[e] *= __builtin_amdgcn_rcpf(h0[e]); g1[e] *= __builtin_amdgcn_rcpf(h1[e]); } }
                    acc[ai][bj][m][0] *= g0; acc[ai][bj][m][1] *= g1;
                    if (b == 3) *(u32x4*)(Mg + r * DM + col0 + bj * HALF) = pack8(acc[ai][bj][m][0], acc[ai][bj][m][1]); } }
    }
};
struct EpiWo {
    static constexpr bool SUBACC = false;
    const float* xin; float* xout; bf16_t* xg; const float* gain; float* part;
    __device__ __forceinline__ void operator()(const Acc& acc, const Unit& u, int wr, int wc, int fr, int fq) const {
        const int row0 = u.pm * BM + wr * 64 + fr, col0 = u.pn * BM + wc * 32 + 8 * fq;
        f32x4 gv[2][2];
#pragma unroll
        for (int bj = 0; bj < 2; ++bj)
#pragma unroll
            for (int n = 0; n < 2; ++n) gv[bj][n] = *(const f32x4*)(gain + col0 + bj * HALF + 4 * n);
#pragma unroll
        for (int ai = 0; ai < 2; ++ai)
#pragma unroll
            for (int m = 0; m < 4; ++m) { const size_t r = (size_t)(row0 + ai * HALF + m * 16); float ss = 0.f;
#pragma unroll
                for (int bj = 0; bj < 2; ++bj) { const size_t off = r * DM + col0 + bj * HALF;
                    const f32x4 v0 = *(const f32x4*)(xin + off) + acc[ai][bj][m][0], v1 = *(const f32x4*)(xin + off + 4) + acc[ai][bj][m][1];
                    *(f32x4*)(xout + off) = v0; *(f32x4*)(xout + off + 4) = v1;
                    ss += (v0[0] * v0[0] + v0[1] * v0[1]) + (v0[2] * v0[2] + v0[3] * v0[3]) + (v1[0] * v1[0] + v1[1] * v1[1]) + (v1[2] * v1[2] + v1[3] * v1[3]);
                    *(u32x4*)(xg + off) = pack8(v0 * gv[bj][0], v1 * gv[bj][1]); }
                ss += __shfl_xor(ss, 16); ss += __shfl_xor(ss, 32);
                if (fq == 0) part[(size_t)(u.pn * 4 + wc) * MTOK + r] = ss; }
    }
};
struct EpiPlain {
    static constexpr bool SUBACC = false;
    bf16_t* O;
    __device__ __forceinline__ void operator()(const Acc& acc, const Unit& u, int wr, int wc, int fr, int fq) const {
        const int row0 = u.pm * BM + wr * 64 + fr, col0 = u.pn * BM + wc * 32 + 8 * fq;
#pragma unroll
        for (int ai = 0; ai < 2; ++ai)
#pragma unroll
            for (int m = 0; m < 4; ++m) { bf16_t* rowp = O + (size_t)(row0 + ai * HALF + m * 16) * DM + col0;
#pragma unroll
                for (int bj = 0; bj < 2; ++bj) *(u32x4*)(rowp + bj * HALF) = pack8(acc[ai][bj][m][0], acc[ai][bj][m][1]); }
    }
};
struct EpiPle {
    static constexpr bool SUBACC = false;
    float* x; const bf16_t* PP; const float* partB; bf16_t* xgn; const float* gain; float* partA; int has_next; const unsigned char* ldsr;
    __device__ __forceinline__ void operator()(const Acc& acc, const Unit& u, int wr, int wc, int fr, int fq) const {
        const int row0 = u.pm * BM + wr * 64 + fr, col0 = u.pn * BM + wc * 32 + 8 * fq; float rs[2][4]; row_rstd_lds(partB, ldsr, u.pm, wr, fr, fq, rs);
        f32x4 gv[2][2];
#pragma unroll
        for (int bj = 0; bj < 2; ++bj)
#pragma unroll
            for (int n = 0; n < 2; ++n) gv[bj][n] = has_next ? *(const f32x4*)(gain + col0 + bj * HALF + 4 * n) : (f32x4){0.f, 0.f, 0.f, 0.f};
#pragma unroll
        for (int ai = 0; ai < 2; ++ai)
#pragma unroll
            for (int m = 0; m < 4; ++m) { const size_t r = (size_t)(row0 + ai * HALF + m * 16); float ss = 0.f; const float s = rs[ai][m];
#pragma unroll
                for (int bj = 0; bj < 2; ++bj) { const size_t off = r * DM + col0 + bj * HALF;
                    f32x4 p0, p1; unpack8(*(const u32x4*)(PP + off), p0, p1);
                    f32x4 v0 = *(const f32x4*)(x + off), v1 = *(const f32x4*)(x + off + 4);
#pragma unroll
                    for (int e = 0; e < 4; ++e) { v0[e] += sigm(acc[ai][bj][m][0][e] * s) * p0[e]; v1[e] += sigm(acc[ai][bj][m][1][e] * s) * p1[e]; }
                    *(f32x4*)(x + off) = v0; *(f32x4*)(x + off + 4) = v1;
                    if (has_next) {
                        ss += (v0[0] * v0[0] + v0[1] * v0[1]) + (v0[2] * v0[2] + v0[3] * v0[3]) + (v1[0] * v1[0] + v1[1] * v1[1]) + (v1[2] * v1[2] + v1[3] * v1[3]);
                        *(u32x4*)(xgn + off) = pack8(v0 * gv[bj][0], v1 * gv[bj][1]); } }
                if (has_next) { ss += __shfl_xor(ss, 16); ss += __shfl_xor(ss, 32);
                    if (fq == 0) partA[(size_t)(u.pn * 4 + wc) * MTOK + r] = ss; } }
    }
};
}

struct Args { const float* in[20]; float* out; unsigned char* ws; };
enum { I_X = 0, I_P, I_NMIX, I_WIN, I_CONVW, I_CONVB, I_FGB, I_QN, I_KN, I_LB, I_HGN, I_SGN, I_SPW, I_SPB, I_WUP, I_MB, I_WO, I_NPLE, I_WPG, I_WPP };

__device__ __forceinline__ Args load_args() {
    const volatile __attribute__((address_space(4))) unsigned long long* kp = (const volatile __attribute__((address_space(4))) unsigned long long*)__builtin_amdgcn_kernarg_segment_ptr();
    Args r;
#pragma unroll
    for (int i = 0; i < 20; ++i) r.in[i] = (const float*)kp[i];
    r.out = (float*)kp[20]; r.ws = (unsigned char*)kp[21]; return r;
}
__device__ __forceinline__ void transpose_item(const float* W, int ldw, int K, bf16_t* WT, int drow0, int k0, int srccol, float* scr, int lane) {
    float tv[32];
#pragma unroll
    for (int i = 0; i < 32; ++i) { const int kk = 2 * i + (lane >> 5); tv[i] = (srccol >= 0) ? W[(size_t)(k0 + kk) * ldw + srccol] : 0.f; }
#pragma unroll
    for (int i = 0; i < 32; ++i) { const int kk = 2 * i + (lane >> 5); scr[kk * 33 + (lane & 31)] = tv[i]; }
    asm volatile("s_waitcnt lgkmcnt(0)" ::: "memory");
    const int c = lane & 7;
#pragma unroll
    for (int j = 0; j < 4; ++j) { const int n = (lane >> 3) + 8 * j; const float* s = scr + (8 * c) * 33 + n;
        u32x4 o; o.x = pk2(s[0 * 33], s[1 * 33]); o.y = pk2(s[2 * 33], s[3 * 33]); o.z = pk2(s[4 * 33], s[5 * 33]); o.w = pk2(s[6 * 33], s[7 * 33]);
        *(u32x4*)(WT + (size_t)(drow0 + n) * K + k0 + 8 * c) = o; }
    asm volatile("s_waitcnt lgkmcnt(0)" ::: "memory");
}
__device__ __forceinline__ void convert_win_item(const Args& a, int L, int item, float* scr, int lane) {
    const int kb = item >> 8, db = item & 255, l5 = lane & 31;
    int src;
    if (db < 64) src = 32 * db + l5; else if (db < 120) src = 32 * db + 4 + l5; else if (db == 120) src = (l5 < 4) ? 2048 + l5 : -1; else if (db < 128) src = -1; else src = 3844 + 32 * (db - 128) + l5;
    transpose_item(a.in[I_WIN] + (size_t)L * DM * INC, INC, DM, (bf16_t*)(a.ws + WS_WIN), 32 * db, 64 * kb, src, scr, lane);
}
__device__ __forceinline__ void convert_small_item(const Args& a, int item, float* scr, int lane) {
    const int L = item / 1664; int r = item % 1664; const int l5 = lane & 31;
    if (r < 512) { const int b = r >> 7, q = r & 127, kb = q >> 5, nb = q & 31;
        transpose_item(a.in[I_WUP] + (size_t)(L * 4 + b) * BW * DM, DM, BW, (bf16_t*)(a.ws + WS_WUP) + (size_t)(L * 4 + b) * DM * BW, 32 * nb, 64 * kb, 32 * nb + l5, scr, lane); return; }
    r -= 512;
    if (r < 512) { const int kb = r >> 5, nb = r & 31;
        transpose_item(a.in[I_WO] + (size_t)L * DM * DM, DM, DM, (bf16_t*)(a.ws + WS_WO) + (size_t)L * DM * DM, 32 * nb, 64 * kb, 32 * nb + l5, scr, lane); return; }
    r -= 512;
    if (r < 512) { const int kb = r >> 5, nb = r & 31;
        transpose_item(a.in[I_WPG] + (size_t)L * DM * DM, DM, DM, (bf16_t*)(a.ws + WS_WPG) + (size_t)L * DM * DM, 32 * nb, 64 * kb, 32 * nb + l5, scr, lane); return; }
    r -= 512;
    { const int kb = r >> 5, nb = r & 31;
        transpose_item(a.in[I_WPP] + (size_t)L * PLE * DM, DM, PLE, (bf16_t*)(a.ws + WS_WPP) + (size_t)L * DM * PLE, 32 * nb, 64 * kb, 32 * nb + l5, scr, lane); }
}
__device__ __forceinline__ void convert_p(const Args& a, int L) {
    const float* src = a.in[I_P] + (size_t)L * MTOK * PLE; bf16_t* dst = (bf16_t*)(a.ws + WS_PBF);
    const size_t N = (size_t)MTOK * PLE / 8, stride = (size_t)gridDim.x * NTHR, g0 = (size_t)blockIdx.x * NTHR + opq(threadIdx.x);
    if (N % (4 * stride) == 0) {
        for (size_t i = g0; i < N; i += 4 * stride) { f32x4 v[4][2];
#pragma unroll
            for (int q = 0; q < 4; ++q) { v[q][0] = *(const f32x4*)(src + (i + q * stride) * 8); v[q][1] = *(const f32x4*)(src + (i + q * stride) * 8 + 4); }
#pragma unroll
            for (int q = 0; q < 4; ++q) *(u32x4*)(dst + (i + q * stride) * 8) = pack8(v[q][0], v[q][1]); }
    } else for (size_t i = g0; i < N; i += stride) { const f32x4 v0 = *(const f32x4*)(src + i * 8), v1 = *(const f32x4*)(src + i * 8 + 4); *(u32x4*)(dst + i * 8) = pack8(v0, v1); }
}

__device__ __forceinline__ void conv_item(const bf16_t* Z, bf16_t* Y, const float* cw, const float* cb, int idx) {
    const int t = idx >> 5, c = (idx & 31) * 8, s = t & (SEQ - 1);
    const bf16_t* zr = Z + (size_t)t * ZLD;
    f32x4 acc0 = (f32x4){0.f, 0.f, 0.f, 0.f}, acc1 = acc0;
#pragma unroll
    for (int tap = 0; tap < 3; ++tap) { const int back = (2 - tap) <= s ? (2 - tap) : 0; const float on = (2 - tap) <= s ? 1.f : 0.f;
        f32x4 x0, x1, c0, c1; unpack8(*(const u32x4*)(zr - (size_t)back * ZLD + Z_AX + c), x0, x1); unpack8(*(const u32x4*)(zr - (size_t)back * ZLD + Z_AC + c), c0, c1);
        const f32x4 w0 = *(const f32x4*)(cw + tap * BW + c) * on, w1 = *(const f32x4*)(cw + tap * BW + c + 4) * on;
        acc0 += x0 * c0 * w0; acc1 += x1 * c1 * w1; }
    f32x4 b0, b1, g0, g1; unpack8(*(const u32x4*)(zr + Z_AB + c), b0, b1); unpack8(*(const u32x4*)(zr + Z_AG + c), g0, g1);
    acc0 = b0 * (acc0 + *(const f32x4*)(cb + c)) * silu4(g0); acc1 = b1 * (acc1 + *(const f32x4*)(cb + c + 4)) * silu4(g1);
    *(u32x4*)(Y + (size_t)t * DM + c) = pack8(acc0, acc1);
}
__device__ __forceinline__ void conv_branch(const Args& a, int li) {
    const bf16_t* Z = (const bf16_t*)(a.ws + WS_ZG); bf16_t* Y = (bf16_t*)(a.ws + WS_BUFY);
    const float* cw = a.in[I_CONVW] + (size_t)li * 3 * BW; const float* cb = a.in[I_CONVB] + (size_t)li * BW;
    const int N = MTOK * 32, stride = gridDim.x * NTHR, g0 = blockIdx.x * NTHR + opq(threadIdx.x);
    if (N % (4 * stride) == 0) { for (int base = g0; base < N; base += 4 * stride) {
#pragma unroll
        for (int q = 0; q < 4; ++q) conv_item(Z, Y, cw, cb, base + q * stride); } }
    else for (int idx = g0; idx < N; idx += stride) conv_item(Z, Y, cw, cb, idx);
}
__device__ __forceinline__ void qk_item(bf16_t* Z, const float* gq, const float* gk, int idx) {
    const int t = idx >> 5, h = (idx >> 3) & 3, l8 = idx & 7;
    bf16_t* qp = Z + (size_t)t * ZLD + Z_BQ + 64 * h + 8 * l8; bf16_t* kp = Z + (size_t)t * ZLD + Z_BK + 64 * h + 8 * l8;
    f32x4 q0, q1, k0, k1; unpack8(*(const u32x4*)qp, q0, q1); unpack8(*(const u32x4*)kp, k0, k1);
    float sq = (q0[0] * q0[0] + q0[1] * q0[1]) + (q0[2] * q0[2] + q0[3] * q0[3]) + (q1[0] * q1[0] + q1[1] * q1[1]) + (q1[2] * q1[2] + q1[3] * q1[3]);
    float sk = (k0[0] * k0[0] + k0[1] * k0[1]) + (k0[2] * k0[2] + k0[3] * k0[3]) + (k1[0] * k1[0] + k1[1] * k1[1]) + (k1[2] * k1[2] + k1[3] * k1[3]);
    sq = DPP_ADD(sq, 0xB1); sk = DPP_ADD(sk, 0xB1); sq = DPP_ADD(sq, 0x4E); sk = DPP_ADD(sk, 0x4E);
    sq += __shfl_xor(sq, 4); sk += __shfl_xor(sk, 4);
    const float rq = __builtin_amdgcn_rsqf(sq * (1.0f / HD) + EPS) * (0.125f * LOG2E), rk = __builtin_amdgcn_rsqf(sk * (1.0f / HD) + EPS);
    const f32x4 gq0 = *(const f32x4*)(gq + 8 * l8), gq1 = *(const f32x4*)(gq + 8 * l8 + 4), gk0 = *(const f32x4*)(gk + 8 * l8), gk1 = *(const f32x4*)(gk + 8 * l8 + 4);
    *(u32x4*)qp = pack8(q0 * gq0 * rq, q1 * gq1 * rq); *(u32x4*)kp = pack8(k0 * gk0 * rk, k1 * gk1 * rk);
}
__device__ __forceinline__ void qk_norm(const Args& a, int li) {
    bf16_t* Z = (bf16_t*)(a.ws + WS_ZG); const float* gq = a.in[I_QN] + li * HD; const float* gk = a.in[I_KN] + li * HD;
    const int N = MTOK * 32, stride = gridDim.x * NTHR, g0 = blockIdx.x * NTHR + opq(threadIdx.x);
    if (N % (4 * stride) == 0) { for (int base = g0; base < N; base += 4 * stride) {
#pragma unroll
        for (int q = 0; q < 4; ++q) qk_item(Z, gq, gk, base + q * stride); } }
    else for (int idx = g0; idx < N; idx += stride) qk_item(Z, gq, gk, idx);
}
__device__ __forceinline__ void v_transpose(const Args& a, unsigned char* lds) {
    const bf16_t* Z = (const bf16_t*)(a.ws + WS_ZG); bf16_t* VT = (bf16_t*)(a.ws + WS_VT);
    const int tid = opq(threadIdx.x); const int kv = tid >> 3, dg = tid & 7;
    int u = blockIdx.x, buf = 0;
    u32x4 reg = (u32x4){0u, 0u, 0u, 0u};
    if (u < 2048) { const int bh = u >> 7, tb = u & 127; reg = *(const u32x4*)(Z + (size_t)((bh >> 2) * SEQ + 64 * tb + kv) * ZLD + Z_BV + 64 * (bh & 3) + 8 * dg); }
    for (; u < 2048; u += gridDim.x) {
        bf16_t* tile = (bf16_t*)lds + buf * (64 * 72);
        const int bh = u >> 7, tb = u & 127;
        *(u32x4*)(tile + kv * 72 + 8 * dg) = reg;
        __syncthreads();
        const int un = u + gridDim.x;
        if (un < 2048) { const int bhn = un >> 7, tbn = un & 127; reg = *(const u32x4*)(Z + (size_t)((bhn >> 2) * SEQ + 64 * tbn + kv) * ZLD + Z_BV + 64 * (bhn & 3) + 8 * dg); }
        { const int d = tid >> 3, kg = tid & 7; unsigned w[4];
#pragma unroll
          for (int i = 0; i < 4; ++i) w[i] = (unsigned)tile[(8 * kg + 2 * i) * 72 + d] | ((unsigned)tile[(8 * kg + 2 * i + 1) * 72 + d] << 16);
          *(u32x4*)(VT + ((size_t)bh * 64 + d) * SEQ + 64 * tb + 8 * kg) = (u32x4){w[0], w[1], w[2], w[3]}; }
        buf ^= 1;
    }
    __syncthreads();
}
__device__ __forceinline__ void cum_local(const Args& a, int li, unsigned char* lds) {
    const float* flog = (const float*)(a.ws + WS_FLOG); float* cum = (float*)(a.ws + WS_CUM); float* btot = (float*)(a.ws + WS_BTOT);
    const f32x4 bias = *(const f32x4*)(a.in[I_FGB] + li * 4);
    const int tid = opq(threadIdx.x), lane = tid & 63, wid = tid >> 6; float* wt = (float*)lds;
    for (int u = blockIdx.x; u < 128; u += gridDim.x) {
        const size_t t = (size_t)u * 256 + (tid & 255);
        f32x4 v = *(const f32x4*)(flog + t * 4) + bias;
#pragma unroll
        for (int e = 0; e < 4; ++e) v[e] = fminf(v[e], 0.f) - log1pf(expf(-fabsf(v[e])));
#pragma unroll
        for (int o = 1; o < 64; o <<= 1) {
#pragma unroll
            for (int e = 0; e < 4; ++e) { const float n = __shfl_up(v[e], o); if (lane >= o) v[e] += n; } }
        if (lane == 63) *(f32x4*)(wt + wid * 4) = v;
        __syncthreads();
        if (tid < 256) {
            for (int w = 0; w < wid; ++w) v += *(const f32x4*)(wt + w * 4);
            *(f32x4*)(cum + t * 4) = v;
            if (tid == 255) *(f32x4*)(btot + u * 4) = v;
        }
        __syncthreads();
    }
}
__device__ __forceinline__ float hgrn_lb(const float* lbl, int li, int ch) {
    const float l0 = lbl[ch], l1 = lbl[BW + ch], l2 = lbl[2 * BW + ch], l3 = lbl[3 * BW + ch];
    const float mx = fmaxf(fmaxf(l0, l1), fmaxf(l2, l3));
    const float e0 = expf(l0 - mx), e1 = expf(l1 - mx), e2 = expf(l2 - mx), e3 = expf(l3 - mx), inv = 1.0f / (e0 + e1 + e2 + e3);
    float acc = 0.f; if (li >= 1) acc += e1 * inv; if (li >= 2) acc += e2 * inv; if (li >= 3) acc += e3 * inv;
    return fminf(fmaxf(acc, 0.f), 1.f);
}
__device__ __forceinline__ void hgrn_local(const Args& a, int li, unsigned char* lds) {
    const bf16_t* Z = (const bf16_t*)(a.ws + WS_ZG); float* U = (float*)(a.ws + WS_U); float* dvec = (float*)(a.ws + WS_DVEC);
    const int tid = opq(threadIdx.x), lane = tid & 63, wave = tid >> 6, kg = lane & 3, vg = lane >> 2;
    float* wl = (float*)(lds + wave * 10240);
    for (int u = blockIdx.x * NWAVES + wave; u < 2048; u += gridDim.x * NWAVES) {
        const int bh = u >> 7, ch = u & 127, b = bh >> 2, h = bh & 3; const size_t row0 = (size_t)b * SEQ + 64 * ch;
        const float lb = hgrn_lb(a.in[I_LB], li, 64 * h + lane);
        f32x2 S[8][4];
#pragma unroll
        for (int kp = 0; kp < 8; ++kp)
#pragma unroll
            for (int vv = 0; vv < 4; ++vv) S[kp][vv] = (f32x2){0.f, 0.f};
        float dprod = 1.f;
        const bf16_t* zb = Z + row0 * ZLD + 64 * h + lane;
        bf16_t rf[8], ri[8];
#pragma unroll
        for (int j = 0; j < 8; ++j) { rf[j] = zb[(size_t)j * ZLD + Z_CF]; ri[j] = zb[(size_t)j * ZLD + Z_CI]; }
        for (int tb = 0; tb < 8; ++tb) {
            asm volatile("" ::: "memory");
#pragma unroll
            for (int j = 0; j < 8; ++j) { const float f = bflo(rf[j]), vi = bflo(ri[j]);
                const float sg = sigm(f), g = lb + (1.f - lb) * sg; dprod *= g;
                wl[(j * 3 + 0) * 64 + lane] = g; wl[(j * 3 + 1) * 64 + lane] = (1.f - lb) * (1.f - sg); wl[(j * 3 + 2) * 64 + lane] = vi; }
            if (tb < 7) {
#pragma unroll
                for (int j = 0; j < 8; ++j) { rf[j] = zb[(size_t)(8 * (tb + 1) + j) * ZLD + Z_CF]; ri[j] = zb[(size_t)(8 * (tb + 1) + j) * ZLD + Z_CI]; } }
            asm volatile("" ::: "memory");
#pragma unroll
            for (int j = 0; j < 8; ++j) { f32x4 g4[4], kf4[4];
#pragma unroll
                for (int i = 0; i < 4; ++i) { g4[i] = *(const f32x4*)(wl + (j * 3 + 0) * 64 + 16 * kg + 4 * i); kf4[i] = *(const f32x4*)(wl + (j * 3 + 1) * 64 + 16 * kg + 4 * i); }
                const f32x4 v4 = *(const f32x4*)(wl + (j * 3 + 2) * 64 + 4 * vg);
#pragma unroll
                for (int vv = 0; vv < 4; ++vv) { const f32x2 vvv = (f32x2){v4[vv], v4[vv]};
#pragma unroll
                    for (int kp = 0; kp < 8; ++kp) { const f32x2 gp = (f32x2){g4[kp >> 1][2 * (kp & 1)], g4[kp >> 1][2 * (kp & 1) + 1]}, kfp = (f32x2){kf4[kp >> 1][2 * (kp & 1)], kf4[kp >> 1][2 * (kp & 1) + 1]};
                        S[kp][vv] = gp * S[kp][vv] + kfp * vvv; } } }
        }
        float* up = U + (size_t)u * 4096 + 4 * vg;
#pragma unroll
        for (int kp = 0; kp < 8; ++kp)
#pragma unroll
            for (int e = 0; e < 2; ++e) *(f32x4*)(up + (16 * kg + 2 * kp + e) * 64) = (f32x4){S[kp][0][e], S[kp][1][e], S[kp][2][e], S[kp][3][e]};
        dvec[(size_t)u * 64 + lane] = dprod;
    }
    __syncthreads();
}
__device__ __forceinline__ void spatial_branch(const Args& a, int li, unsigned char* lds) {
    const bf16_t* Z = (const bf16_t*)(a.ws + WS_ZG); bf16_t* Y = (bf16_t*)(a.ws + WS_BUFY);
    bf16_t* WB = (bf16_t*)lds; bf16_t* VT = (bf16_t*)(lds + 34816);
    const int tid = opq(threadIdx.x), lane = tid & 63, wid = tid >> 6, r32 = lane & 31, hi = lane >> 5;
    int gloaded = -1;
    for (int u = blockIdx.x; u < 1024; u += gridDim.x) {
        const int ci = u >> 2, g = u & 3; const size_t row0 = (size_t)ci * 128;
        const float* gv = a.in[I_SGN] + li * BW + 64 * g;
        if (g != gloaded) { const float* wsrc = a.in[I_SPW] + ((size_t)li * NH + g) * 128 * 128; gloaded = g;
#pragma unroll
            for (int i = 0; i < 4; ++i) { const int e8 = i * NTHR + tid, t = e8 >> 4, s0 = (e8 & 15) * 8;
                f32x4 w0 = *(const f32x4*)(wsrc + t * 128 + s0), w1 = *(const f32x4*)(wsrc + t * 128 + s0 + 4);
#pragma unroll
                for (int j = 0; j < 4; ++j) { if (s0 + j > t) w0[j] = 0.f; if (s0 + 4 + j > t) w1[j] = 0.f; }
                *(u32x4*)(WB + t * 136 + s0) = pack8(w0, w1); } }
#pragma unroll
        for (int pass = 0; pass < 2; ++pass) { const int r = (tid >> 3) + 64 * pass, l8 = tid & 7;
            f32x4 v0, v1; unpack8(*(const u32x4*)(Z + (row0 + r) * ZLD + Z_DV + 64 * g + 8 * l8), v0, v1);
            float ss = (v0[0] * v0[0] + v0[1] * v0[1]) + (v0[2] * v0[2] + v0[3] * v0[3]) + (v1[0] * v1[0] + v1[1] * v1[1]) + (v1[2] * v1[2] + v1[3] * v1[3]);
#pragma unroll
            for (int o = 1; o < 8; o <<= 1) ss += __shfl_xor(ss, o);
            const float rstd = 1.0f / sqrtf(ss * (1.0f / HD) + EPS);
            v0 = v0 * rstd * *(const f32x4*)(gv + 8 * l8); v1 = v1 * rstd * *(const f32x4*)(gv + 8 * l8 + 4);
#pragma unroll
            for (int j = 0; j < 4; ++j) { VT[(8 * l8 + j) * 136 + r] = (bf16_t)f2bf(v0[j]); VT[(8 * l8 + 4 + j) * 136 + r] = (bf16_t)f2bf(v1[j]); } }
        __syncthreads();
        { const int tb = wid >> 1, cb = wid & 1;
          f32x16 acc;
#pragma unroll
          for (int r = 0; r < 16; ++r) acc[r] = 0.f;
          const bf16_t* ap = VT + (32 * cb + r32) * 136 + 8 * hi; const bf16_t* bp = WB + (32 * tb + r32) * 136 + 8 * hi;
          for (int ks = 0; ks < 2 * (tb + 1); ++ks) acc = __builtin_amdgcn_mfma_f32_32x32x16_bf16(*(const bf16x8*)(ap + 16 * ks), *(const bf16x8*)(bp + 16 * ks), acc, 0, 0, 0);
          const int t = 32 * tb + r32; const float bs = a.in[I_SPB][((size_t)li * NH + g) * 128 + t];
#pragma unroll
          for (int rr = 0; rr < 4; ++rr) { const int c0 = 32 * cb + 8 * rr + 4 * hi;
              const bf16_t* zr = Z + (row0 + t) * ZLD + 64 * g + c0; const u32x2 uw = *(const u32x2*)(zr + Z_DU), gw = *(const u32x2*)(zr + Z_DG);
              const float o0 = bflo(uw.x) * (acc[4 * rr + 0] + bs) * silu(bflo(gw.x)), o1 = bfhi(uw.x) * (acc[4 * rr + 1] + bs) * silu(bfhi(gw.x)),
                          o2 = bflo(uw.y) * (acc[4 * rr + 2] + bs) * silu(bflo(gw.y)), o3 = bfhi(uw.y) * (acc[4 * rr + 3] + bs) * silu(bfhi(gw.y));
              *(u32x2*)(Y + (row0 + t) * DM + 768 + 64 * g + c0) = (u32x2){pk2(o0, o1), pk2(o2, o3)}; } }
        __syncthreads();
    }
}
__device__ __forceinline__ void hgrn_scan(const Args& a, int unit) {
    float* U = (float*)(a.ws + WS_U); const float* dvec = (const float*)(a.ws + WS_DVEC);
    const int bh = unit >> 3, e = (unit & 7) * 512 + opq(threadIdx.x), k = e >> 6;
    float st = 0.f;
    for (int c0 = 0; c0 < 128; c0 += 32) { float uv[32], dv[32];
#pragma unroll
        for (int j = 0; j < 32; ++j) { uv[j] = U[((size_t)(bh * 128 + c0 + j)) * 4096 + e]; dv[j] = dvec[(size_t)(bh * 128 + c0 + j) * 64 + k]; }
#pragma unroll
        for (int j = 0; j < 32; ++j) { U[((size_t)(bh * 128 + c0 + j)) * 4096 + e] = st; st = dv[j] * st + uv[j]; } }
}
__device__ __forceinline__ int pi32(int m) { return (m & 19) | ((m >> 1) & 4) | ((m << 1) & 8); }
__device__ __forceinline__ void attn_unit(const Args& a, int li, unsigned char* lds, int b, int h, int qb) {
    const bf16_t* Z = (const bf16_t*)(a.ws + WS_ZG); const bf16_t* VT = (const bf16_t*)(a.ws + WS_VT); bf16_t* Y = (bf16_t*)(a.ws + WS_BUFY);
    const float* cum = (const float*)(a.ws + WS_CUM); const float* btot = (const float*)(a.ws + WS_BTOT);
    unsigned char* Ks = lds; unsigned char* Vs = lds + 18432; float* cks = (float*)(lds + 36864); float* offs = (float*)(lds + 37376); float* tmp = (float*)(lds + 37504);
    float* thrp = (float*)(lds + 37632); int* cntp = (int*)(lds + 37636);
    const int tid = opq(threadIdx.x), lane = tid & 63, wid = tid >> 6, r32 = lane & 31, hi = lane >> 5;
    const size_t rowb = (size_t)b * SEQ; const int t0 = 256 * qb, bh = b * 4 + h;
    if (tid < 32) tmp[tid] = btot[(b * 32 + tid) * 4 + h];
    if (wid == 1) { float mq = fabsf(a.in[I_QN][li * HD + lane]), mk = fabsf(a.in[I_KN][li * HD + lane]);
#pragma unroll
        for (int o = 1; o < 64; o <<= 1) { mq = fmaxf(mq, __shfl_xor(mq, o)); mk = fmaxf(mk, __shfl_xor(mk, o)); }
        if (lane == 0) { *thrp = 32.0f + 2.0f * 1.02f * 8.0f * mq * mk; *cntp = 0; } }
    __syncthreads();
    if (tid == 0) { float run = 0.f; for (int i = 0; i < 32; ++i) { offs[i] = run; run += tmp[i]; } }
    __syncthreads();
    { const float cq0 = offs[qb] + cum[(rowb + t0) * 4 + h];
      if (tid < 4 * qb) { const int tl = 64 * tid + 63; const float cl = offs[tl >> 8] + cum[(rowb + tl) * 4 + h]; if (cq0 - cl < -(*thrp)) atomicAdd(cntp, 1); } }
    __syncthreads();
    const int jstart = *cntp, jend = 4 * qb + 3;
    const int tq = t0 + 32 * wid + r32;
    const float cq2 = (offs[qb] + cum[(rowb + tq) * 4 + h]) * LOG2E;
    bf16x8 qr[4];
#pragma unroll
    for (int d0 = 0; d0 < 4; ++d0) qr[d0] = *(const bf16x8*)(Z + (rowb + tq) * ZLD + Z_BQ + 64 * h + 16 * d0 + 8 * hi);
    f32x16 o0, o1;
#pragma unroll
    for (int r = 0; r < 16; ++r) { o0[r] = 0.f; o1[r] = 0.f; }
    float mrun = -1e30f, lrun = 0.f;
    const int srow = tid >> 3, sc8 = tid & 7;
    const bf16_t* kgp = Z + (rowb + srow) * ZLD + Z_BK + 64 * h + 8 * sc8;
    const bf16_t* vgp = VT + ((size_t)bh * 64 + srow) * SEQ + 8 * sc8;
    const int krow = pi32(r32);
    u32x4 kA = *(const u32x4*)(kgp + (size_t)(64 * jstart) * ZLD), vA = *(const u32x4*)(vgp + 64 * jstart), kB = kA, vB = vA;
    float cA = 0.f, cB = 0.f;
    if (tid < 64) { const int t = 64 * jstart + tid; cA = -(offs[t >> 8] + cum[(rowb + t) * 4 + h]) * LOG2E; }
    if (jstart + 1 <= jend) { kB = *(const u32x4*)(kgp + (size_t)(64 * (jstart + 1)) * ZLD); vB = *(const u32x4*)(vgp + 64 * (jstart + 1));
        if (tid < 64) { const int t = 64 * (jstart + 1) + tid; cB = -(offs[t >> 8] + cum[(rowb + t) * 4 + h]) * LOG2E; } }
#define ATT_STEP(KR, VR, CR, JT, BUF) do { const int jt_ = (JT); \
        unsigned char* Kb = Ks + (BUF) * 9216; unsigned char* Vb = Vs + (BUF) * 9216; float* cb = cks + (BUF) * 64; \
        *(u32x4*)(Kb + srow * 144 + sc8 * 16) = KR; *(u32x4*)(Vb + srow * 144 + sc8 * 16) = VR; if (tid < 64) cb[tid] = CR; \
        __syncthreads(); \
        if (jt_ + 2 <= jend) { KR = *(const u32x4*)(kgp + (size_t)(64 * (jt_ + 2)) * ZLD); VR = *(const u32x4*)(vgp + 64 * (jt_ + 2)); \
            if (tid < 64) { const int t = 64 * (jt_ + 2) + tid; CR = -(offs[t >> 8] + cum[(rowb + t) * 4 + h]) * LOG2E; } } \
        const int tile_lo = 64 * jt_, wq_lo = t0 + 32 * wid; \
        if (tile_lo <= wq_lo + 31) { \
            f32x16 p0, p1; \
            _Pragma("unroll") for (int r = 0; r < 16; ++r) { p0[r] = cq2; p1[r] = cq2; } \
            _Pragma("unroll") for (int d0 = 0; d0 < 4; ++d0) { \
                const bf16x8 k0 = *(const bf16x8*)(Kb + krow * 144 + 32 * d0 + 16 * hi), k1 = *(const bf16x8*)(Kb + (32 + krow) * 144 + 32 * d0 + 16 * hi); \
                p0 = __builtin_amdgcn_mfma_f32_32x32x16_bf16(k0, qr[d0], p0, 0, 0, 0); p1 = __builtin_amdgcn_mfma_f32_32x32x16_bf16(k1, qr[d0], p1, 0, 0, 0); } \
            const bool need_mask = (tile_lo + 63 > wq_lo); \
            float rm = -1e30f; \
            _Pragma("unroll") for (int g = 0; g < 4; ++g) { \
                const int kv0 = 32 * (g >> 1) + 16 * (g & 1) + 8 * hi; const f32x4 c0 = *(const f32x4*)(cb + kv0), c1 = *(const f32x4*)(cb + kv0 + 4); \
                _Pragma("unroll") for (int e = 0; e < 8; ++e) { const float ck = e < 4 ? c0[e & 3] : c1[e & 3]; const int r = (g & 1) * 8 + e; \
                    float s = (g < 2 ? p0[r] : p1[r]) + ck; \
                    if (need_mask && (tile_lo + kv0 + e > tq)) s = -1e30f; \
                    if (g < 2) p0[r] = s; else p1[r] = s; rm = fmaxf(rm, s); } } \
            rm = fmaxf(rm, __shfl_xor(rm, 32)); \
            const float mnew = fmaxf(mrun, rm), alpha = __builtin_amdgcn_exp2f(mrun - mnew); mrun = mnew; \
            float ls = 0.f; \
            _Pragma("unroll") for (int r = 0; r < 16; ++r) { p0[r] = __builtin_amdgcn_exp2f(p0[r] - mnew); p1[r] = __builtin_amdgcn_exp2f(p1[r] - mnew); ls += p0[r] + p1[r]; } \
            lrun = lrun * alpha + ls; \
            _Pragma("unroll") for (int r = 0; r < 16; ++r) { o0[r] *= alpha; o1[r] *= alpha; } \
            bf16x8 pa[4]; \
            _Pragma("unroll") for (int j = 0; j < 4; ++j) { u32x4 w; \
                if (j < 2) { w.x = pk2(p0[8 * (j & 1) + 0], p0[8 * (j & 1) + 1]); w.y = pk2(p0[8 * (j & 1) + 2], p0[8 * (j & 1) + 3]); w.z = pk2(p0[8 * (j & 1) + 4], p0[8 * (j & 1) + 5]); w.w = pk2(p0[8 * (j & 1) + 6], p0[8 * (j & 1) + 7]); } \
                else { w.x = pk2(p1[8 * (j & 1) + 0], p1[8 * (j & 1) + 1]); w.y = pk2(p1[8 * (j & 1) + 2], p1[8 * (j & 1) + 3]); w.z = pk2(p1[8 * (j & 1) + 4], p1[8 * (j & 1) + 5]); w.w = pk2(p1[8 * (j & 1) + 6], p1[8 * (j & 1) + 7]); } \
                pa[j] = __builtin_bit_cast(bf16x8, w); } \
            _Pragma("unroll") for (int j = 0; j < 4; ++j) { \
                const bf16x8 v0 = *(const bf16x8*)(Vb + r32 * 144 + (16 * j + 8 * hi) * 2), v1 = *(const bf16x8*)(Vb + (32 + r32) * 144 + (16 * j + 8 * hi) * 2); \
                o0 = __builtin_amdgcn_mfma_f32_32x32x16_bf16(v0, pa[j], o0, 0, 0, 0); o1 = __builtin_amdgcn_mfma_f32_32x32x16_bf16(v1, pa[j], o1, 0, 0, 0); } \
        } } while (0)
    for (int jt = jstart; jt <= jend; jt += 2) {
        ATT_STEP(kA, vA, cA, jt, 0);
        if (jt + 1 <= jend) ATT_STEP(kB, vB, cB, jt + 1, 1);
    }
#undef ATT_STEP
    lrun += __shfl_xor(lrun, 32);
    const float rl = 1.0f / lrun;
    const bf16_t* zg = Z + (rowb + tq) * ZLD + Z_BG + 64 * h; bf16_t* yr = Y + (rowb + tq) * DM + 256 + 64 * h;
#pragma unroll
    for (int dh = 0; dh < 2; ++dh)
#pragma unroll
        for (int rr = 0; rr < 4; ++rr) { const int d = 32 * dh + 8 * rr + 4 * hi; const u32x2 gw = *(const u32x2*)(zg + d);
            const float g0 = silu(bflo(gw.x)), g1 = silu(bfhi(gw.x)), g2 = silu(bflo(gw.y)), g3 = silu(bfhi(gw.y));
            const float v0 = (dh ? o1[4 * rr + 0] : o0[4 * rr + 0]) * rl * g0, v1 = (dh ? o1[4 * rr + 1] : o0[4 * rr + 1]) * rl * g1,
                        v2 = (dh ? o1[4 * rr + 2] : o0[4 * rr + 2]) * rl * g2, v3 = (dh ? o1[4 * rr + 3] : o0[4 * rr + 3]) * rl * g3;
            *(u32x2*)(yr + d) = (u32x2){pk2(v0, v1), pk2(v2, v3)}; }
    __syncthreads();
}
__device__ __forceinline__ void hgrn_out(const Args& a, int li, unsigned char* lds) {
    const bf16_t* Z = (const bf16_t*)(a.ws + WS_ZG); const float* U = (const float*)(a.ws + WS_U); bf16_t* Y = (bf16_t*)(a.ws + WS_BUFY);
    const int tid = opq(threadIdx.x), lane = tid & 63, wave = tid >> 6, kg = lane & 3, vg = lane >> 2;
    float* wl = (float*)(lds + wave * 10240);
    for (int u = blockIdx.x * NWAVES + wave; u < 2048; u += gridDim.x * NWAVES) {
        const int bh = u >> 7, ch = u & 127, b = bh >> 2, h = bh & 3; const size_t row0 = (size_t)b * SEQ + 64 * ch;
        const float lb = hgrn_lb(a.in[I_LB], li, 64 * h + lane);
        const float gain = a.in[I_HGN][li * BW + 64 * h + lane];
        const bf16_t* zb = Z + row0 * ZLD + 64 * h + lane;
        bf16_t rq[8], rf[8], ri[8], rg[8];
#pragma unroll
        for (int j = 0; j < 8; ++j) { rq[j] = zb[(size_t)j * ZLD + Z_CQ]; rf[j] = zb[(size_t)j * ZLD + Z_CF]; ri[j] = zb[(size_t)j * ZLD + Z_CI]; rg[j] = zb[(size_t)j * ZLD + Z_CG]; }
        f32x2 S[8][4];
        { const float* up = U + (size_t)u * 4096 + 4 * vg;
#pragma unroll
          for (int kp = 0; kp < 8; ++kp) { const f32x4 r0 = *(const f32x4*)(up + (16 * kg + 2 * kp) * 64), r1 = *(const f32x4*)(up + (16 * kg + 2 * kp + 1) * 64);
#pragma unroll
              for (int vv = 0; vv < 4; ++vv) S[kp][vv] = (f32x2){r0[vv], r1[vv]}; } }
        for (int tb = 0; tb < 8; ++tb) {
            asm volatile("" ::: "memory");
#pragma unroll
            for (int j = 0; j < 8; ++j) { const float q = bflo(rq[j]), f = bflo(rf[j]), vi = bflo(ri[j]), gt = bflo(rg[j]);
                const float sg = sigm(f);
                wl[(j * 5 + 0) * 64 + lane] = lb + (1.f - lb) * sg; wl[(j * 5 + 1) * 64 + lane] = (1.f - lb) * (1.f - sg); wl[(j * 5 + 2) * 64 + lane] = silu(q);
                wl[(j * 5 + 3) * 64 + lane] = vi; wl[(j * 5 + 4) * 64 + lane] = silu(gt) * gain; }
            if (tb < 7) {
#pragma unroll
                for (int j = 0; j < 8; ++j) { const size_t o = (size_t)(8 * (tb + 1) + j) * ZLD; rq[j] = zb[o + Z_CQ]; rf[j] = zb[o + Z_CF]; ri[j] = zb[o + Z_CI]; rg[j] = zb[o + Z_CG]; } }
            asm volatile("" ::: "memory");
#pragma unroll
            for (int j = 0; j < 8; ++j) { f32x4 g4[4], kf4[4], q4[4];
#pragma unroll
                for (int i = 0; i < 4; ++i) { g4[i] = *(const f32x4*)(wl + (j * 5 + 0) * 64 + 16 * kg + 4 * i); kf4[i] = *(const f32x4*)(wl + (j * 5 + 1) * 64 + 16 * kg + 4 * i); q4[i] = *(const f32x4*)(wl + (j * 5 + 2) * 64 + 16 * kg + 4 * i); }
                const f32x4 v4 = *(const f32x4*)(wl + (j * 5 + 3) * 64 + 4 * vg), gt4 = *(const f32x4*)(wl + (j * 5 + 4) * 64 + 4 * vg);
                f32x4 o;
#pragma unroll
                for (int vv = 0; vv < 4; ++vv) { const f32x2 vvv = (f32x2){v4[vv], v4[vv]}; f32x2 o2 = (f32x2){0.f, 0.f};
#pragma unroll
                    for (int kp = 0; kp < 8; ++kp) { const f32x2 gp = (f32x2){g4[kp >> 1][2 * (kp & 1)], g4[kp >> 1][2 * (kp & 1) + 1]}, kfp = (f32x2){kf4[kp >> 1][2 * (kp & 1)], kf4[kp >> 1][2 * (kp & 1) + 1]},
                                                                qp = (f32x2){q4[kp >> 1][2 * (kp & 1)], q4[kp >> 1][2 * (kp & 1) + 1]};
                        S[kp][vv] = gp * S[kp][vv] + kfp * vvv; o2 += qp * S[kp][vv]; }
                    float ov = o2[0] + o2[1]; ov = DPP_ADD(ov, 0xB1); ov = DPP_ADD(ov, 0x4E); o[vv] = ov; }
                float ss = (o[0] * o[0] + o[1] * o[1]) + (o[2] * o[2] + o[3] * o[3]);
                ss = DPP_ADD(ss, 0x124); ss = DPP_ADD(ss, 0x128);
                ss += __shfl_xor(ss, 16); ss += __shfl_xor(ss, 32);
                const float rstd = __builtin_amdgcn_rsqf(ss * (1.0f / HD) + EPS);
                if (kg == 0) *(u32x2*)(Y + (row0 + 8 * tb + j) * DM + 512 + 64 * h + 4 * vg) = (u32x2){pk2(o[0] * rstd * gt4[0], o[1] * rstd * gt4[1]), pk2(o[2] * rstd * gt4[2], o[3] * rstd * gt4[3])}; }
        }
    }
    __syncthreads();
}

#define XB_TMO      128
#define XB_XCNT(j)  (256  + 64 * (j))
#define XB_XSUB(j)  (1280 + 64 * (j))
#define XB_XGEN(j)  (2304 + 64 * (j))
#define XB_TOP      3328
#define XB_TOPGEN   3392
#define XCD_BAR_WORDS 3456
#define XB_SPIN_CAP (1u << 18)
__device__ __forceinline__ unsigned xb_ld(unsigned* p)              { return __hip_atomic_load(p, __ATOMIC_RELAXED, __HIP_MEMORY_SCOPE_AGENT); }
__device__ __forceinline__ unsigned xb_add(unsigned* p, unsigned v) { return __hip_atomic_fetch_add(p, v, __ATOMIC_RELAXED, __HIP_MEMORY_SCOPE_AGENT); }
__device__ __forceinline__ unsigned xb_xcc_id() { return (unsigned)__builtin_amdgcn_s_getreg((3 << 11) | 20) & 0xFu; }
#define XB_SPIN(cond, bar) do { unsigned _sp = 0; while (cond) { __builtin_amdgcn_s_sleep(1); \
    if ((++_sp & 255u) == 0u) { if (xb_ld(&(bar)[XB_TMO])) break; if (_sp > XB_SPIN_CAP) { atomicAdd(&(bar)[XB_TMO], 1u); break; } } } } while (0)
struct XcdBarrier { unsigned* bar; unsigned x; volatile LAS unsigned* st; };
__device__ __forceinline__ XcdBarrier xcd_barrier_post(unsigned* bar, volatile LAS unsigned* st) {
    XcdBarrier b; b.bar = bar; b.x = xb_xcc_id(); b.st = st;
    if (threadIdx.x == 0) (void)xb_add(&bar[XB_XCNT(b.x)], 1u);
    return b;
}
__device__ __forceinline__ void xcd_barrier_complete(unsigned* bar, unsigned x, unsigned& nloc, unsigned& nx) {
    const unsigned G = gridDim.x * gridDim.y * gridDim.z;
    unsigned sum, cnt, mine, sp = 0u;
    for (;;) {
        sum = 0u; cnt = 0u; mine = 0u;
#pragma unroll
        for (unsigned j = 0; j < 16; ++j) { const unsigned c = xb_ld(&bar[XB_XCNT(j)]); sum += c; cnt += (c > 0u) ? 1u : 0u; mine = (j == x) ? c : mine; }
        if (sum == G) break;
        __builtin_amdgcn_s_sleep(1);
        if ((++sp & 255u) == 0u) { if (xb_ld(&bar[XB_TMO])) break; if (sp > XB_SPIN_CAP) { atomicAdd(&bar[XB_TMO], 1u); break; } }
    }
    nloc = mine > 0u ? mine : 1u; nx = cnt > 0u ? cnt : 1u;
}
__device__ __forceinline__ void xcd_barrier(const XcdBarrier& b) {
    asm volatile("s_waitcnt vmcnt(0)" ::: "memory");
    __syncthreads();
    if (threadIdx.x == 0) {
        unsigned* bar = b.bar;
        __builtin_amdgcn_s_waitcnt(0);
        unsigned nloc = b.st[0], nx = b.st[1];
        if (nloc == 0u) { xcd_barrier_complete(bar, b.x, nloc, nx); b.st[0] = nloc; b.st[1] = nx; }
        const unsigned old = xb_add(&bar[XB_XSUB(b.x)], 1u);
        const unsigned gen = old / nloc;
        if (old + 1u == (gen + 1u) * nloc) {
            __builtin_amdgcn_fence(__ATOMIC_RELEASE, "agent");
            asm volatile("s_waitcnt vmcnt(0)" ::: "memory");
            const unsigned og = xb_add(&bar[XB_TOP], 1u);
            const unsigned tg = og / nx;
            if (og + 1u == (tg + 1u) * nx) xb_add(&bar[XB_TOPGEN], 1u);
            else XB_SPIN(xb_ld(&bar[XB_TOPGEN]) == tg, bar);
            __builtin_amdgcn_fence(__ATOMIC_ACQUIRE, "agent");
            xb_add(&bar[XB_XGEN(b.x)], 1u);
            asm volatile("s_waitcnt vmcnt(0)" ::: "memory");
        } else {
            XB_SPIN(xb_ld(&bar[XB_XGEN(b.x)]) == gen, bar);
            __builtin_amdgcn_fence(__ATOMIC_ACQUIRE, "agent");
            asm volatile("s_waitcnt vmcnt(0)" ::: "memory");
        }
    }
    __syncthreads();
}

#ifndef PHM
#define PHM 0xFFFF
#endif
#define PH(b) ((PHM >> (b)) & 1)
#ifndef REP_P1
#define REP_P1 1
#endif
#ifndef REP_SYNC
#define REP_SYNC 0
#endif
#ifndef REP_ATT
#define REP_ATT 1
#endif
#ifndef REP_HO
#define REP_HO 1
#endif
#ifndef REP_P2A
#define REP_P2A 1
#endif
#ifndef REP_P3A
#define REP_P3A 1
#endif
#ifndef REP_P3B
#define REP_P3B 1
#endif
__global__ void __launch_bounds__(NTHR, 2) mega_fwd(Args a) {
    extern __shared__ __attribute__((aligned(16))) unsigned char lds_raw[];
    cg::grid_group grid = cg::this_grid();
    LAS unsigned char* ldsl = (LAS unsigned char*)lds_raw;
    const int tid = threadIdx.x, lane = tid & 63, wave = tid >> 6;
    const int G = gridDim.x, bx = blockIdx.x;
    unsigned char* ws = a.ws;
    bf16_t* WIN = (bf16_t*)(ws + WS_WIN); bf16_t* BUFH = (bf16_t*)(ws + WS_BUFH); bf16_t* BUFY = (bf16_t*)(ws + WS_BUFY); bf16_t* ZG = (bf16_t*)(ws + WS_ZG);
    float* SSA = (float*)(ws + WS_SSA); float* SSB = (float*)(ws + WS_SSB);
    float* scr = (float*)(lds_raw + wave * 16384);
    const int gw = bx * NWAVES + wave, NGW = G * NWAVES;
    if (tid < 2) ((volatile LAS unsigned*)(ldsl + 131072 + 128))[tid] = 0u;
    __syncthreads();
    const XcdBarrier xbar = xcd_barrier_post((unsigned*)ws, (volatile LAS unsigned*)(ldsl + 131072 + 128));
#define GSYNC() xcd_barrier(xbar)

    if (PH(0)) {
    for (int it = gw; it < 6656; it += NGW) convert_small_item(a, it, scr, lane);
    for (int it = gw; it < 4096; it += NGW) convert_win_item(a, 0, it, scr, lane);
    convert_p(a, 0);
    { const f32x4* gr = (const f32x4*)a.in[I_NMIX] + lane; f32x4 gg[4];
#pragma unroll
      for (int j = 0; j < 4; ++j) gg[j] = gr[64 * j];
      const int rstep = (MTOK % (4 * NGW) == 0) ? 4 : 1;
      for (int m0 = gw; m0 < MTOK; m0 += rstep * NGW) {
        f32x4 v[4][4];
#pragma unroll
        for (int q = 0; q < 4; ++q) if (q < rstep) { const f32x4* xr = (const f32x4*)(a.in[I_X] + (size_t)(m0 + q * NGW) * DM) + lane;
#pragma unroll
            for (int j = 0; j < 4; ++j) v[q][j] = xr[64 * j]; }
#pragma unroll
        for (int q = 0; q < 4; ++q) if (q < rstep) { const int m = m0 + q * NGW; float sq = 0.f;
            u32x2* o8 = (u32x2*)(BUFH + (size_t)m * DM) + lane;
#pragma unroll
            for (int j = 0; j < 4; ++j) { const f32x4 x4 = v[q][j]; sq += (x4[0] * x4[0] + x4[1] * x4[1]) + (x4[2] * x4[2] + x4[3] * x4[3]);
                o8[64 * j] = (u32x2){pk2(x4[0] * gg[j][0], x4[1] * gg[j][1]), pk2(x4[2] * gg[j][2], x4[3] * gg[j][3])}; }
#pragma unroll
            for (int o = 1; o < 64; o <<= 1) sq += __shfl_xor(sq, o);
            if (lane < 16) SSA[(size_t)lane * MTOK + m] = lane == 0 ? sq : 0.f; }
      }
    }
    }
    grid.sync();

    for (int li = 0; li < DEPTH; ++li) {
        for (int rep = 0; rep < REP_P1; ++rep) if (PH(1)) { pg8::Gemm g{BUFH, WIN, DM, DM, DM, 0, 0}; pg8::StaticOrder S; S.init(MTOK, 4096, G, bx);
          pg8::stage_rstd(SSA, S, lds_raw);
          pg8::EpiZ E{ZG, (float*)(ws + WS_FLOG), SSA, lds_raw};
          pg8::gemm_phase(ldsl, g, S, E); }
        GSYNC();
        for (int rep = 0; rep < REP_P2A; ++rep) {
        if (PH(2)) conv_branch(a, li);
        if (PH(3) && rep == 0) qk_norm(a, li);
        if (PH(4)) v_transpose(a, lds_raw);
        if (PH(5)) cum_local(a, li, lds_raw);
        if (PH(6)) hgrn_local(a, li, lds_raw);
        if (PH(7)) spatial_branch(a, li, lds_raw);
        }
        GSYNC();
        if (PH(8)) if (bx >= G - 128) { hgrn_scan(a, bx - (G - 128));
            asm volatile("s_waitcnt vmcnt(0)" ::: "memory"); __syncthreads();
            if (threadIdx.x == 0) { __builtin_amdgcn_fence(__ATOMIC_RELEASE, "agent"); asm volatile("s_waitcnt vmcnt(0)" ::: "memory");
                __hip_atomic_fetch_add((unsigned*)(ws + 45056) + li * 64, 1u, __ATOMIC_RELAXED, __HIP_MEMORY_SCOPE_AGENT); } }
        if (PH(9)) {
            unsigned* qctr = (unsigned*)(ws + 32768) + li * 64; int* qslot = (int*)(lds_raw + 37640);
            for (;;) {
                if (threadIdx.x == 0) *qslot = (int)__hip_atomic_fetch_add(qctr, 1u, __ATOMIC_RELAXED, __HIP_MEMORY_SCOPE_AGENT);
                __syncthreads();
                const int q = *qslot;
                __syncthreads();
                if (q >= 512) break;
                attn_unit(a, li, lds_raw, q & 3, 3 - (q >> 7), 31 - ((q & 127) >> 2));
            }
        }
        if (threadIdx.x == 0) { unsigned* fl = (unsigned*)(ws + 45056) + li * 64; unsigned sp = 0u;
            while (__hip_atomic_load(fl, __ATOMIC_RELAXED, __HIP_MEMORY_SCOPE_AGENT) < 128u) { __builtin_amdgcn_s_sleep(2); if (++sp > (1u << 22)) break; }
            __builtin_amdgcn_fence(__ATOMIC_ACQUIRE, "agent"); asm volatile("s_waitcnt vmcnt(0)" ::: "memory"); }
        __syncthreads();
        for (int rep = 0; rep < REP_HO; ++rep) if (PH(10)) hgrn_out(a, li, lds_raw);
        GSYNC();
        for (int hf = 0; hf < 2; ++hf) {
            for (int rep = 0; rep < REP_P3A; ++rep) if (PH(11)) { pg8::Gemm g{BUFH, WIN + (size_t)4096 * DM, DM, DM, DM, 0, 0}; pg8::StaticOrder S; S.init(MTOK / 2, 4096, G, bx, hf * (MTOK / 512));
              pg8::stage_rstd(SSA, S, lds_raw);
              pg8::EpiGate E{ZG, SSA, a.in[I_MB] + (size_t)li * 4096, lds_raw};
              pg8::gemm_phase(ldsl, g, S, E); }
            GSYNC();
            for (int rep = 0; rep < REP_P3B; ++rep) if (PH(12)) { pg8::Gemm g{BUFY, (const bf16_t*)(ws + WS_WUP) + (size_t)li * 4 * DM * BW, DM, BW, BW, (size_t)BW * 2, (size_t)DM * BW * 2}; pg8::SubOrder S; S.so.init(MTOK / 2, DM, G, bx, hf * (MTOK / 512));
              pg8::EpiMerge E{ZG, BUFH};
              pg8::gemm_phase(ldsl, g, S, E); }
        }
        GSYNC();
        if (PH(13)) { pg8::Gemm g{BUFH, (const bf16_t*)(ws + WS_WO) + (size_t)li * DM * DM, DM, DM, DM, 0, 0}; pg8::StaticOrder S; S.init(MTOK, DM, G, bx);
          pg8::EpiWo E{li == 0 ? a.in[I_X] : (const float*)a.out, a.out, BUFY, a.in[I_NPLE] + (size_t)li * DM, SSB};
          pg8::gemm_phase(ldsl, g, S, E); }
        if (PH(14)) { pg8::Gemm g{(const bf16_t*)(ws + WS_PBF), (const bf16_t*)(ws + WS_WPP) + (size_t)li * DM * PLE, PLE, PLE, PLE, 0, 0}; pg8::StaticOrder S; S.init(MTOK, DM, G, bx);
          pg8::EpiPlain E{ZG};
          pg8::gemm_phase(ldsl, g, S, E); }
        GSYNC();
        if (li + 1 < DEPTH) { const int t2 = opq(threadIdx.x), lane2 = t2 & 63, wave2 = t2 >> 6; float* scr2 = (float*)(lds_raw + wave2 * 16384);
            for (int it = bx * NWAVES + wave2; it < 4096; it += NGW) convert_win_item(a, li + 1, it, scr2, lane2); convert_p(a, li + 1); __syncthreads(); }
        if (PH(15)) { pg8::Gemm g{BUFY, (const bf16_t*)(ws + WS_WPG) + (size_t)li * DM * DM, DM, DM, DM, 0, 0}; pg8::StaticOrder S; S.init(MTOK, DM, G, bx);
          pg8::stage_rstd(SSB, S, lds_raw);
          pg8::EpiPle E{a.out, ZG, SSB, BUFH, a.in[I_NMIX] + (size_t)(li + 1 < DEPTH ? li + 1 : 0) * DM, SSA, li + 1 < DEPTH ? 1 : 0, lds_raw};
          pg8::gemm_phase(ldsl, g, S, E); }
        if (li + 1 < DEPTH) GSYNC();
    }
}

extern "C" void kernel_launch(void* const* d_in, const int* in_sizes, int n_in, void* d_out, int out_size, void* d_ws, size_t ws_size, hipStream_t stream) {
    static int grid = 0;
    if (grid == 0) {
        if (n_in != 20 || out_size != MTOK * DM || ws_size < WS_END) { fprintf(stderr, "kernel_launch: unexpected shapes (n_in %d, out %d, ws %zu)\n", n_in, out_size, ws_size); grid = -1; return; }
        int dev = 0, cus = 0, per_cu = 0;
        (void)hipGetDevice(&dev); (void)hipDeviceGetAttribute(&cus, hipDeviceAttributeMultiprocessorCount, dev);
        (void)hipFuncSetAttribute((const void*)mega_fwd, hipFuncAttributeMaxDynamicSharedMemorySize, LDS_BYTES);
        (void)hipOccupancyMaxActiveBlocksPerMultiprocessor(&per_cu, (const void*)mega_fwd, NTHR, LDS_BYTES);
        if (per_cu < 1) per_cu = 1;
        grid = cus * per_cu; if (grid > 256) grid = 256;
        if (grid != 256) { fprintf(stderr, "kernel_launch: this kernel needs a grid of exactly 256 co-resident workgroups (got %d); nothing launched\n", grid); grid = -1; return; }
        (void)hipGetLastError();
    }
    if (grid < 0) return;
    if (hipMemsetAsync(d_ws, 0, 65536, stream) != hipSuccess) { fprintf(stderr, "kernel_launch: memset failed\n"); return; }
    Args a{};
    for (int i = 0; i < 20; ++i) a.in[i] = (const float*)d_in[i];
    a.out = (float*)d_out; a.ws = (unsigned char*)d_ws;
    void* params[] = {&a};
    hipError_t e = hipLaunchCooperativeKernel((const void*)mega_fwd, dim3(grid), dim3(NTHR), params, LDS_BYTES, stream);
    if (e != hipSuccess) fprintf(stderr, "cooperative launch failed: %s (grid %d)\n", hipGetErrorString(e), grid);
}
```

```cpp
#include <hip/hip_runtime.h>
#include <hip/hip_cooperative_groups.h>
#include <cstdio>
#include <cstdint>
namespace cg = cooperative_groups;

#define LAS __attribute__((address_space(3)))
typedef unsigned short bf16_t;
typedef short bf16x8 __attribute__((ext_vector_type(8)));
typedef float f32x4 __attribute__((ext_vector_type(4)));
typedef float f32x16 __attribute__((ext_vector_type(16)));
typedef unsigned u32x4 __attribute__((ext_vector_type(4)));
typedef unsigned u32x2 __attribute__((ext_vector_type(2)));

constexpr int MTOK = 32768, DM = 1024, SEQ = 8192, NBAT = 4, BW = 256, NH = 4, HD = 64, DEPTH = 4, PLE = 256, INC = 7940;
constexpr int ZLD = 3840;
constexpr int Z_AX = 0, Z_AB = 256, Z_AC = 512, Z_AG = 768, Z_BQ = 1024, Z_BK = 1280, Z_BV = 1536, Z_BG = 1792,
              Z_CQ = 2048, Z_CF = 2304, Z_CI = 2560, Z_CG = 2816, Z_DU = 3072, Z_DV = 3328, Z_DG = 3584;
constexpr float EPS = 1e-6f, LOG2E = 1.4426950408889634f;
constexpr int NTHR = 512, NWAVES = 8;
constexpr int LDS_BYTES = 147456;

constexpr size_t MiB = 1u << 20;
constexpr size_t WS_WIN = 1 * MiB;
constexpr size_t WS_WUP = 17 * MiB;
constexpr size_t WS_WO = 25 * MiB;
constexpr size_t WS_WPG = 33 * MiB;
constexpr size_t WS_WPP = 41 * MiB;
constexpr size_t WS_PBF = 43 * MiB;
constexpr size_t WS_SSA = 59 * MiB;
constexpr size_t WS_SSB = 61 * MiB;
constexpr size_t WS_FLOG = 63 * MiB;
constexpr size_t WS_CUM = 63 * MiB + 512 * 1024;
constexpr size_t WS_BTOT = 64 * MiB;
constexpr size_t WS_DVEC = 64 * MiB + 512 * 1024;
constexpr size_t WS_VT = 66 * MiB;
constexpr size_t WS_U = 82 * MiB;
constexpr size_t WS_BUFH = 114 * MiB;
constexpr size_t WS_BUFY = 178 * MiB;
constexpr size_t WS_ZG = 242 * MiB;
constexpr size_t WS_END = 498 * MiB;

__device__ __forceinline__ unsigned f2bf(float f) { unsigned u = __builtin_bit_cast(unsigned, f); return (u + 0x7fffu + ((u >> 16) & 1u)) >> 16; }
typedef float f32x2 __attribute__((ext_vector_type(2)));
typedef __bf16 bf16x2_t __attribute__((ext_vector_type(2)));
__device__ __forceinline__ unsigned pk2(float lo, float hi) { const f32x2 v = {lo, hi}; const bf16x2_t b = __builtin_convertvector(v, bf16x2_t); return __builtin_bit_cast(unsigned, b); }
__device__ __forceinline__ float bflo(unsigned u) { return __builtin_bit_cast(float, u << 16); }
__device__ __forceinline__ float bfhi(unsigned u) { return __builtin_bit_cast(float, u & 0xffff0000u); }
__device__ __forceinline__ void unpack8(u32x4 w, f32x4& a, f32x4& b) { a = (f32x4){bflo(w.x), bfhi(w.x), bflo(w.y), bfhi(w.y)}; b = (f32x4){bflo(w.z), bfhi(w.z), bflo(w.w), bfhi(w.w)}; }
__device__ __forceinline__ u32x4 pack8(f32x4 a, f32x4 b) { u32x4 w; w.x = pk2(a[0], a[1]); w.y = pk2(a[2], a[3]); w.z = pk2(b[0], b[1]); w.w = pk2(b[2], b[3]); return w; }
#define DPP_ADD(v, ctrl) ((v) + __builtin_bit_cast(float, __builtin_amdgcn_update_dpp(0, __builtin_bit_cast(int, (v)), (ctrl), 0xF, 0xF, true)))
__device__ __forceinline__ int opq(int v) { asm volatile("" : "+v"(v)); return v; }
__device__ __forceinline__ float sigm(float x) { return __builtin_amdgcn_rcpf(1.f + __expf(-x)); }
__device__ __forceinline__ float silu(float x) { return x * __builtin_amdgcn_rcpf(1.f + __expf(-x)); }
__device__ __forceinline__ f32x4 silu4(f32x4 v) { return (f32x4){silu(v[0]), silu(v[1]), silu(v[2]), silu(v[3])}; }

namespace pg8 {
constexpr int BM = 256, BK = 64, HALF = 128, HTB = HALF * BK * 2, STAGE_BYTES = 8 * HTB, NXCD = 8, WGM = 8;
__host__ __device__ __forceinline__ int lds_byte(int r, int c) { const int st = (r >> 4) * 2 + (c >> 5), rr = r & 15, cc = c & 31, ob = rr * 64 + cc * 2; return st * 1024 + (ob ^ (((ob >> 9) & 1) << 5)); }
__host__ __device__ __forceinline__ void stage_rc(int b, int& R, int& C) { const int st = b / 1024, sb = b % 1024, swz = sb ^ (((sb >> 9) & 1) << 5); R = (st >> 1) * 16 + swz / 64; C = (st & 1) * 32 + (swz % 64) / 2; }
__host__ __device__ __forceinline__ int perm32(int rho) { const int n = rho >> 4, i = rho & 15; return 8 * (i >> 2) + 4 * n + (i & 3); }

struct Unit { int pm, pn, sub; };
struct Gemm { const bf16_t* A; const bf16_t* Bt; int lda, ldb, K; size_t subA, subB; };

struct StaticOrder {
    int nM, nN, nwg, G, c, pm0;
    __device__ void init(int M, int N, int G_, int c_, int pm0_ = 0) { nM = M / BM; nN = N / BM; nwg = nM * nN; G = G_; c = c_; pm0 = pm0_; }
    __device__ bool next(int i, Unit& u) const {
        const long L = (long)i * G + c; if (L >= nwg) return false;
        int wgid = (int)L; { const int q = nwg / NXCD, r = nwg % NXCD, xcd = wgid % NXCD, off = wgid / NXCD; wgid = (xcd < r ? xcd * (q + 1) : r * (q + 1) + (xcd - r) * q) + off; }
        const int nig = WGM * nN, gid = wgid / nig, fm = gid * WGM, gsz = (nM - fm) < WGM ? (nM - fm) : WGM;
        u.pm = pm0 + fm + ((wgid % nig) % gsz); u.pn = (wgid % nig) / gsz; u.sub = 0; return true;
    }
};
struct SubOrder {
    StaticOrder so;
    __device__ bool next(int i, Unit& u) const { if (!so.next(i >> 2, u)) return false; u.sub = i & 3; return true; }
};

template <class Epi, class Sched>
__device__ __forceinline__ void gemm_phase(LAS unsigned char* lds, const Gemm g, const Sched& S, const Epi& E) {
    int tid_ = threadIdx.x; asm volatile("" : "+v"(tid_));
    const int tid = tid_, wid = __builtin_amdgcn_readfirstlane(tid >> 6), lane = tid & 63, wr = wid >> 2, wc = wid & 3, fr = lane & 15, fq = lane >> 4;
    const int K = g.K; int nt_ = K / BK; asm volatile("" : "+s"(nt_)); const int nt = nt_;
    unsigned voffA[2], voffB[2];
#pragma unroll
    for (int i = 0; i < 2; ++i) { int R, C; stage_rc(tid * 16 + i * 8192, R, C); const int Rb = (R & ~31) + perm32(R & 31);
        voffA[i] = (unsigned)(R * g.lda + C) * 2u; voffB[i] = (unsigned)(Rb * g.ldb + C) * 2u; }
    const size_t kstep = (size_t)(BK * 2);
    const size_t hstepA = (size_t)HALF * g.lda * 2, hstepB = (size_t)HALF * g.ldb * 2;
    const size_t tstepA = 2 * hstepA, tstepB = 2 * hstepB;
    const unsigned ldsw = (unsigned)wid * 1024u;
    const int aoff = lds_byte(wr * 64 + fr, fq * 8), boff = lds_byte(wc * 32 + fr, fq * 8);
#define PG8_SA(b, h) (((b) * 2 + (h)) * HTB)
#define PG8_SB(b, h) ((4 + (b) * 2 + (h)) * HTB)
#define PG8_STAGE(bufoff, gbase, voff) do { _Pragma("unroll") for (int _i = 0; _i < 2; ++_i) \
        __builtin_amdgcn_global_load_lds((const unsigned*)((const char*)(gbase) + (voff)[_i]), (LAS unsigned*)(lds + (bufoff) + ldsw + _i * 8192), 16, 0, 0); } while (0)
#define PG8_LDA(dst, b, h) do { _Pragma("unroll") for (int m = 0; m < 4; ++m) _Pragma("unroll") for (int k = 0; k < 2; ++k) dst[m][k] = *(const LAS bf16x8*)(lds + PG8_SA(b, h) + aoff + m * 2048 + k * 1024); } while (0)
#define PG8_LDB(dst, b, h) do { _Pragma("unroll") for (int n = 0; n < 2; ++n) _Pragma("unroll") for (int k = 0; k < 2; ++k) dst[n][k] = *(const LAS bf16x8*)(lds + PG8_SB(b, h) + boff + n * 2048 + k * 1024); } while (0)
#define PG8_MMA(ai, bj, At, Bt) do { __builtin_amdgcn_s_setprio(1); _Pragma("unroll") for (int m = 0; m < 4; ++m) _Pragma("unroll") for (int n = 0; n < 2; ++n) _Pragma("unroll") for (int k = 0; k < 2; ++k) \
        acc[ai][bj][m][n] = __builtin_amdgcn_mfma_f32_16x16x32_bf16(Bt[n][k], At[m][k], acc[ai][bj][m][n], 0, 0, 0); __builtin_amdgcn_s_setprio(0); } while (0)
#define PG8_WAIT_V(n) asm volatile("s_waitcnt vmcnt(" #n ")" ::: "memory")
#define PG8_WAIT_L(n) asm volatile("s_waitcnt lgkmcnt(" #n ")" ::: "memory")
#define PG8_BAR __builtin_amdgcn_s_barrier()
#define PG8_SCHED __builtin_amdgcn_sched_barrier(0)
    Unit cur, nxt; int ui = 0;
    if (!S.next(0, cur)) return;
    f32x4 acc[2][2][4][2];
#pragma unroll
    for (int a = 0; a < 2; ++a)
#pragma unroll
        for (int b = 0; b < 2; ++b)
#pragma unroll
            for (int m = 0; m < 4; ++m)
#pragma unroll
                for (int n = 0; n < 2; ++n) acc[a][b][m][n] = (f32x4){0.f, 0.f, 0.f, 0.f};
    bf16x8 At[4][2], B0[2][2], B1[2][2];
    const char* cA = (const char*)g.A + (size_t)cur.pm * tstepA + (size_t)cur.sub * g.subA;
    const char* cB = (const char*)g.Bt + (size_t)cur.pn * tstepB + (size_t)cur.sub * g.subB;
    PG8_STAGE(PG8_SB(0, 0), cB, voffB); PG8_STAGE(PG8_SB(0, 1), cB + hstepB, voffB); PG8_STAGE(PG8_SA(0, 0), cA, voffA); PG8_STAGE(PG8_SA(0, 1), cA + hstepA, voffA);
    if (wr == 1) PG8_BAR;
    PG8_WAIT_V(2); PG8_BAR;
    PG8_STAGE(PG8_SB(1, 0), cB + kstep, voffB); PG8_STAGE(PG8_SA(1, 0), cA + kstep, voffA); PG8_STAGE(PG8_SB(1, 1), cB + hstepB + kstep, voffB);
    PG8_WAIT_V(6); PG8_BAR;
    for (;;) {
        const bool has_next = S.next(ui + 1, nxt);
        const char* nA = has_next ? (const char*)g.A + (size_t)nxt.pm * tstepA + (size_t)nxt.sub * g.subA : cA;
        const char* nB = has_next ? (const char*)g.Bt + (size_t)nxt.pn * tstepB + (size_t)nxt.sub * g.subB : cB;
        for (int t = 0; t < nt; t += 2) {
            const bool last = (t == nt - 2);
            const char* a1 = cA + (size_t)(t + 1) * kstep;
            const char* a2 = last ? nA : cA + (size_t)(t + 2) * kstep; const char* b2 = last ? nB : cB + (size_t)(t + 2) * kstep;
            const char* a3 = a2 + kstep; const char* b3 = b2 + kstep;
            PG8_LDB(B0, 0, 0); PG8_LDB(B1, 0, 1); PG8_SCHED; PG8_LDA(At, 0, 0); PG8_STAGE(PG8_SA(1, 1), a1 + hstepA, voffA);
            PG8_WAIT_V(8); PG8_WAIT_L(0); PG8_BAR; PG8_MMA(0, 0, At, B0); PG8_MMA(0, 1, At, B1); PG8_BAR; PG8_SCHED;
            PG8_LDA(At, 0, 1); PG8_STAGE(PG8_SB(0, 0), b2, voffB); PG8_STAGE(PG8_SB(0, 1), b2 + hstepB, voffB); PG8_STAGE(PG8_SA(0, 0), a2, voffA);
            PG8_WAIT_V(8); PG8_WAIT_L(0); PG8_BAR; PG8_MMA(1, 0, At, B0); PG8_MMA(1, 1, At, B1); PG8_BAR; PG8_SCHED;
            PG8_LDB(B0, 1, 0); PG8_LDB(B1, 1, 1); PG8_SCHED; PG8_LDA(At, 1, 0); PG8_STAGE(PG8_SA(0, 1), a2 + hstepA, voffA);
            PG8_WAIT_V(8); PG8_WAIT_L(0); PG8_BAR; PG8_MMA(0, 0, At, B0); PG8_MMA(0, 1, At, B1); PG8_BAR; PG8_SCHED;
            PG8_LDA(At, 1, 1); PG8_STAGE(PG8_SB(1, 0), b3, voffB); PG8_STAGE(PG8_SB(1, 1), b3 + hstepB, voffB); PG8_STAGE(PG8_SA(1, 0), a3, voffA);
            PG8_WAIT_V(8); PG8_WAIT_L(0); PG8_BAR; PG8_MMA(1, 0, At, B0); PG8_MMA(1, 1, At, B1); PG8_BAR; PG8_SCHED;
        }
        if (wr == 0) PG8_BAR;
        E(acc, cur, wr, wc, fr, fq);
        if (!has_next) break;
        if (!(Epi::SUBACC && nxt.sub != 0)) {
#pragma unroll
            for (int a = 0; a < 2; ++a)
#pragma unroll
                for (int b = 0; b < 2; ++b)
#pragma unroll
                    for (int m = 0; m < 4; ++m)
#pragma unroll
                        for (int n = 0; n < 2; ++n) acc[a][b][m][n] = (f32x4){0.f, 0.f, 0.f, 0.f};
        }
        cur = nxt; cA = nA; cB = nB; ++ui;
        if (wr == 1) PG8_BAR;
    }
    PG8_WAIT_V(0);
    PG8_BAR;
#undef PG8_SA
#undef PG8_SB
#undef PG8_STAGE
#undef PG8_LDA
#undef PG8_LDB
#undef PG8_MMA
#undef PG8_WAIT_V
#undef PG8_WAIT_L
#undef PG8_BAR
#undef PG8_SCHED
}

typedef f32x4 Acc[2][2][4][2];
__device__ __forceinline__ void row_rstd(const float* part, int row0, int fq, float (&rs)[2][4]) {
#pragma unroll
    for (int ai = 0; ai < 2; ++ai)
#pragma unroll
        for (int m = 0; m < 4; ++m) { const int r = row0 + ai * HALF + m * 16; float s = 0.f;
#pragma unroll
            for (int j = 0; j < 4; ++j) s += part[(size_t)(4 * fq + j) * MTOK + r];
            s += __shfl_xor(s, 16); s += __shfl_xor(s, 32);
            rs[ai][m] = 1.0f / sqrtf(s * (1.0f / DM) + EPS); }
}

template <class Sched>
__device__ __forceinline__ void stage_rstd(const float* part, const Sched& S, unsigned char* lds_raw) {
    float* tab = (float*)(lds_raw + 131072 + 1024); int* tags = (int*)(lds_raw + 131072 + 512);
    Unit u; int last = -1, slot = 0; const int tid = opq(threadIdx.x);
    for (int i = 0; slot < 4 && S.next(i, u); ++i) { if (u.pm == last) continue; last = u.pm;
        if (tid < 256) { const int r = u.pm * BM + tid; float s = 0.f;
#pragma unroll
            for (int j = 0; j < 16; ++j) s += part[(size_t)j * MTOK + r];
            tab[slot * 256 + tid] = 1.0f / sqrtf(s * (1.0f / DM) + EPS); }
        if (tid == 0) tags[slot] = u.pm;
        ++slot; }
    for (; slot < 4; ++slot) if (tid == 0) tags[slot] = -1;
    __syncthreads();
}
__device__ __forceinline__ void row_rstd_lds(const float* part, const unsigned char* lds_raw, int pm, int wr, int fr, int fq, float (&rs)[2][4]) {
    const float* tab = (const float*)(lds_raw + 131072 + 1024); const int* tags = (const int*)(lds_raw + 131072 + 512);
    int slot = -1;
#pragma unroll
    for (int k = 0; k < 4; ++k) if (tags[k] == pm) slot = k;
    if (slot < 0) slot = 0;
#pragma unroll
    for (int ai = 0; ai < 2; ++ai)
#pragma unroll
        for (int m = 0; m < 4; ++m) rs[ai][m] = tab[slot * 256 + ai * HALF + wr * 64 + m * 16 + fr];
}

struct EpiZ {
    static constexpr bool SUBACC = false;
    bf16_t* Z; float* flog; const float* part; const unsigned char* ldsr;
    __device__ __forceinline__ void operator()(const Acc& acc, const Unit& u, int wr, int wc, int fr, int fq) const {
        const int row0 = u.pm * BM + wr * 64 + fr; float rs[2][4]; row_rstd_lds(part, ldsr, u.pm, wr, fr, fq, rs);
        if (u.pn < 15) {
            const int col0 = u.pn * BM + wc * 32 + 8 * fq;
#pragma unroll
            for (int ai = 0; ai < 2; ++ai)
#pragma unroll
                for (int m = 0; m < 4; ++m) { bf16_t* rowp = Z + (size_t)(row0 + ai * HALF + m * 16) * ZLD + col0; const float s = rs[ai][m];
#pragma unroll
                    for (int bj = 0; bj < 2; ++bj) *(u32x4*)(rowp + bj * HALF) = pack8(acc[ai][bj][m][0] * s, acc[ai][bj][m][1] * s); }
        } else if (wc == 0 && fq == 0) {
#pragma unroll
            for (int ai = 0; ai < 2; ++ai)
#pragma unroll
                for (int m = 0; m < 4; ++m) *(f32x4*)(flog + (size_t)(row0 + ai * HALF + m * 16) * 4) = acc[ai][0][m][0] * rs[ai][m];
        }
    }
};
struct EpiGate {
    static constexpr bool SUBACC = false;
    bf16_t* G; const float* part; const float* mb; const unsigned char* ldsr;
    __device__ __forceinline__ void operator()(const Acc& acc, const Unit& u, int wr, int wc, int fr, int fq) const {
        const int row0 = u.pm * BM + wr * 64 + fr; float rs[2][4]; row_rstd_lds(part, ldsr, u.pm, wr, fr, fq, rs);
        const int col0 = u.pn * BM + wc * 32 + 8 * fq;
        f32x4 bv[2][2];
#pragma unroll
        for (int bj = 0; bj < 2; ++bj)
#pragma unroll
            for (int n = 0; n < 2; ++n) bv[bj][n] = *(const f32x4*)(mb + col0 + bj * HALF + 4 * n);
#pragma unroll
        for (int ai = 0; ai < 2; ++ai)
#pragma unroll
            for (int m = 0; m < 4; ++m) { bf16_t* rowp = G + (size_t)(row0 + ai * HALF + m * 16) * 4096 + col0; const float s = rs[ai][m];
#pragma unroll
                for (int bj = 0; bj < 2; ++bj) { f32x4 v0 = acc[ai][bj][m][0] * s + bv[bj][0], v1 = acc[ai][bj][m][1] * s + bv[bj][1];
#pragma unroll
                    for (int e = 0; e < 4; ++e) { v0[e] = fmaxf(sigm(v0[e]), 9.3132257e-10f); v1[e] = fmaxf(sigm(v1[e]), 9.3132257e-10f); }
                    *(u32x4*)(rowp + bj * HALF) = pack8(v0, v1); } }
    }
};
struct EpiMerge {
    static constexpr bool SUBACC = true;
    const bf16_t* G; bf16_t* Mg;
    __device__ __forceinline__ void operator()(Acc& acc, const Unit& u, int wr, int wc, int fr, int fq) const {
        const int row0 = u.pm * BM + wr * 64 + fr, col0 = u.pn * BM + wc * 32 + 8 * fq, b = u.sub;
#pragma unroll
        for (int ai = 0; ai < 2; ++ai)
#pragma unroll
            for (int m = 0; m < 4; ++m) { const size_t r = (size_t)(row0 + ai * HALF + m * 16);
#pragma unroll
                for (int bj = 0; bj < 2; ++bj) {
                    const bf16_t* gp = G + r * 4096 + b * 1024 + col0 + bj * HALF;
                    f32x4 g0, g1; unpack8(*(const u32x4*)gp, g0, g1);
                    if (b < 3) { f32x4 h0, h1; unpack8(*(const u32x4*)(gp + 1024), h0, h1);
#pragma unroll
                        for (int e = 0; e < 4; ++e) { g0[e] *= __builtin_amdgcn_rcpf(h0[e]); g1[e] *= __builtin_amdgcn_rcpf(h1[e]); } }
                    acc[ai][bj][m][0] *= g0; acc[ai][bj][m][1] *= g1;
                    if (b == 3) *(u32x4*)(Mg + r * DM + col0 + bj * HALF) = pack8(acc[ai][bj][m][0], acc[ai][bj][m][1]); } }
    }
};
struct EpiWo {
    static constexpr bool SUBACC = false;
    const float* xin; float* xout; bf16_t* xg; const float* gain; float* part;
    __device__ __forceinline__ void operator()(const Acc& acc, const Unit& u, int wr, int wc, int fr, int fq) const {
        const int row0 = u.pm * BM + wr * 64 + fr, col0 = u.pn * BM + wc * 32 + 8 * fq;
        f32x4 gv[2][2];
#pragma unroll
        for (int bj = 0; bj < 2; ++bj)
#pragma unroll
            for (int n = 0; n < 2; ++n) gv[bj][n] = *(const f32x4*)(gain + col0 + bj * HALF + 4 * n);
#pragma unroll
        for (int ai = 0; ai < 2; ++ai)
#pragma unroll
            for (int m = 0; m < 4; ++m) { const size_t r = (size_t)(row0 + ai * HALF + m * 16); float ss = 0.f;
#pragma unroll
                for (int bj = 0; bj < 2; ++bj) { const size_t off = r * DM + col0 + bj * HALF;
                    const f32x4 v0 = *(const f32x4*)(xin + off) + acc[ai][bj][m][0], v1 = *(const f32x4*)(xin + off + 4) + acc[ai][bj][m][1];
                    *(f32x4*)(xout + off) = v0; *(f32x4*)(xout + off + 4) = v1;
                    ss += (v0[0] * v0[0] + v0[1] * v0[1]) + (v0[2] * v0[2] + v0[3] * v0[3]) + (v1[0] * v1[0] + v1[1] * v1[1]) + (v1[2] * v1[2] + v1[3] * v1[3]);
                    *(u32x4*)(xg + off) = pack8(v0 * gv[bj][0], v1 * gv[bj][1]); }
                ss += __shfl_xor(ss, 16); ss += __shfl_xor(ss, 32);
                if (fq == 0) part[(size_t)(u.pn * 4 + wc) * MTOK + r] = ss; }
    }
};
struct EpiPlain {
    static constexpr bool SUBACC = false;
    bf16_t* O;
    __device__ __forceinline__ void operator()(const Acc& acc, const Unit& u, int wr, int wc, int fr, int fq) const {
        const int row0 = u.pm * BM + wr * 64 + fr, col0 = u.pn * BM + wc * 32 + 8 * fq;
#pragma unroll
        for (int ai = 0; ai < 2; ++ai)
#pragma unroll
            for (int m = 0; m < 4; ++m) { bf16_t* rowp = O + (size_t)(row0 + ai * HALF + m * 16) * DM + col0;
#pragma unroll
                for (int bj = 0; bj < 2; ++bj) *(u32x4*)(rowp + bj * HALF) = pack8(acc[ai][bj][m][0], acc[ai][bj][m][1]); }
    }
};
struct EpiPle {
    static constexpr bool SUBACC = false;
    float* x; const bf16_t* PP; const float* partB; bf16_t* xgn; const float* gain; float* partA; int has_next; const unsigned char* ldsr;
    __device__ __forceinline__ void operator()(const Acc& acc, const Unit& u, int wr, int wc, int fr, int fq) const {
        const int row0 = u.pm * BM + wr * 64 + fr, col0 = u.pn * BM + wc * 32 + 8 * fq; float rs[2][4]; row_rstd_lds(partB, ldsr, u.pm, wr, fr, fq, rs);
        f32x4 gv[2][2];
#pragma unroll
        for (int bj = 0; bj < 2; ++bj)
#pragma unroll
            for (int n = 0; n < 2; ++n) gv[bj][n] = has_next ? *(const f32x4*)(gain + col0 + bj * HALF + 4 * n) : (f32x4){0.f, 0.f, 0.f, 0.f};
#pragma unroll
        for (int ai = 0; ai < 2; ++ai)
#pragma unroll
            for (int m = 0; m < 4; ++m) { const size_t r = (size_t)(row0 + ai * HALF + m * 16); float ss = 0.f; const float s = rs[ai][m];
#pragma unroll
                for (int bj = 0; bj < 2; ++bj) { const size_t off = r * DM + col0 + bj * HALF;
                    f32x4 p0, p1; unpack8(*(const u32x4*)(PP + off), p0, p1);
                    f32x4 v0 = *(const f32x4*)(x + off), v1 = *(const f32x4*)(x + off + 4);
#pragma unroll
                    for (int e = 0; e < 4; ++e) { v0[e] += sigm(acc[ai][bj][m][0][e] * s) * p0[e]; v1[e] += sigm(acc[ai][bj][m][1][e] * s) * p1[e]; }
                    *(f32x4*)(x + off) = v0; *(f32x4*)(x + off + 4) = v1;
                    if (has_next) {
                        ss += (v0[0] * v0[0] + v0[1] * v0[1]) + (v0[2] * v0[2] + v0[3] * v0[3]) + (v1[0] * v1[0] + v1[1] * v1[1]) + (v1[2] * v1[2] + v1[3] * v1[3]);
                        *(u32x4*)(xgn + off) = pack8(v0 * gv[bj][0], v1 * gv[bj][1]); } }
                if (has_next) { ss += __shfl_xor(ss, 16); ss += __shfl_xor(ss, 32);
                    if (fq == 0) partA[(size_t)(u.pn * 4 + wc) * MTOK + r] = ss; } }
    }
};
}

struct Args { const float* in[20]; float* out; unsigned char* ws; };
enum { I_X = 0, I_P, I_NMIX, I_WIN, I_CONVW, I_CONVB, I_FGB, I_QN, I_KN, I_LB, I_HGN, I_SGN, I_SPW, I_SPB, I_WUP, I_MB, I_WO, I_NPLE, I_WPG, I_WPP };

__device__ __forceinline__ Args load_args() {
    const volatile __attribute__((address_space(4))) unsigned long long* kp = (const volatile __attribute__((address_space(4))) unsigned long long*)__builtin_amdgcn_kernarg_segment_ptr();
    Args r;
#pragma unroll
    for (int i = 0; i < 20; ++i) r.in[i] = (const float*)kp[i];
    r.out = (float*)kp[20]; r.ws = (unsigned char*)kp[21]; return r;
}
__device__ __forceinline__ void transpose_item(const float* W, int ldw, int K, bf16_t* WT, int drow0, int k0, int srccol, float* scr, int lane) {
#pragma unroll 8
    for (int i = 0; i < 32; ++i) { const int kk = 2 * i + (lane >> 5); scr[kk * 33 + (lane & 31)] = (srccol >= 0) ? W[(size_t)(k0 + kk) * ldw + srccol] : 0.f; }
    asm volatile("s_waitcnt lgkmcnt(0)" ::: "memory");
    const int c = lane & 7;
#pragma unroll
    for (int j = 0; j < 4; ++j) { const int n = (lane >> 3) + 8 * j; const float* s = scr + (8 * c) * 33 + n;
        u32x4 o; o.x = pk2(s[0 * 33], s[1 * 33]); o.y = pk2(s[2 * 33], s[3 * 33]); o.z = pk2(s[4 * 33], s[5 * 33]); o.w = pk2(s[6 * 33], s[7 * 33]);
        *(u32x4*)(WT + (size_t)(drow0 + n) * K + k0 + 8 * c) = o; }
    asm volatile("s_waitcnt lgkmcnt(0)" ::: "memory");
}
__device__ __forceinline__ void convert_win_item(const Args& a, int L, int item, float* scr, int lane) {
    const int kb = item >> 8, db = item & 255, l5 = lane & 31;
    int src;
    if (db < 64) src = 32 * db + l5; else if (db < 120) src = 32 * db + 4 + l5; else if (db == 120) src = (l5 < 4) ? 2048 + l5 : -1; else if (db < 128) src = -1; else src = 3844 + 32 * (db - 128) + l5;
    transpose_item(a.in[I_WIN] + (size_t)L * DM * INC, INC, DM, (bf16_t*)(a.ws + WS_WIN), 32 * db, 64 * kb, src, scr, lane);
}
__device__ __forceinline__ void convert_small_item(const Args& a, int item, float* scr, int lane) {
    const int L = item / 1664; int r = item % 1664; const int l5 = lane & 31;
    if (r < 512) { const int b = r >> 7, q = r & 127, kb = q >> 5, nb = q & 31;
        transpose_item(a.in[I_WUP] + (size_t)(L * 4 + b) * BW * DM, DM, BW, (bf16_t*)(a.ws + WS_WUP) + (size_t)(L * 4 + b) * DM * BW, 32 * nb, 64 * kb, 32 * nb + l5, scr, lane); return; }
    r -= 512;
    if (r < 512) { const int kb = r >> 5, nb = r & 31;
        transpose_item(a.in[I_WO] + (size_t)L * DM * DM, DM, DM, (bf16_t*)(a.ws + WS_WO) + (size_t)L * DM * DM, 32 * nb, 64 * kb, 32 * nb + l5, scr, lane); return; }
    r -= 512;
    if (r < 512) { const int kb = r >> 5, nb = r & 31;
        transpose_item(a.in[I_WPG] + (size_t)L * DM * DM, DM, DM, (bf16_t*)(a.ws + WS_WPG) + (size_t)L * DM * DM, 32 * nb, 64 * kb, 32 * nb + l5, scr, lane); return; }
    r -= 512;
    { const int kb = r >> 5, nb = r & 31;
        transpose_item(a.in[I_WPP] + (size_t)L * PLE * DM, DM, PLE, (bf16_t*)(a.ws + WS_WPP) + (size_t)L * DM * PLE, 32 * nb, 64 * kb, 32 * nb + l5, scr, lane); }
}
__device__ __forceinline__ void convert_p(const Args& a, int L) {
    const float* src = a.in[I_P] + (size_t)L * MTOK * PLE; bf16_t* dst = (bf16_t*)(a.ws + WS_PBF);
    for (size_t i = (size_t)blockIdx.x * NTHR + opq(threadIdx.x); i < (size_t)MTOK * PLE / 8; i += (size_t)gridDim.x * NTHR) {
        const f32x4 v0 = *(const f32x4*)(src + i * 8), v1 = *(const f32x4*)(src + i * 8 + 4); *(u32x4*)(dst + i * 8) = pack8(v0, v1); }
}

__device__ __forceinline__ void conv_item(const bf16_t* Z, bf16_t* Y, const float* cw, const float* cb, int idx) {
    const int t = idx >> 5, c = (idx & 31) * 8, s = t & (SEQ - 1);
    const bf16_t* zr = Z + (size_t)t * ZLD;
    f32x4 acc0 = (f32x4){0.f, 0.f, 0.f, 0.f}, acc1 = acc0;
#pragma unroll
    for (int tap = 0; tap < 3; ++tap) { const int back = (2 - tap) <= s ? (2 - tap) : 0; const float on = (2 - tap) <= s ? 1.f : 0.f;
        f32x4 x0, x1, c0, c1; unpack8(*(const u32x4*)(zr - (size_t)back * ZLD + Z_AX + c), x0, x1); unpack8(*(const u32x4*)(zr - (size_t)back * ZLD + Z_AC + c), c0, c1);
        const f32x4 w0 = *(const f32x4*)(cw + tap * BW + c) * on, w1 = *(const f32x4*)(cw + tap * BW + c + 4) * on;
        acc0 += x0 * c0 * w0; acc1 += x1 * c1 * w1; }
    f32x4 b0, b1, g0, g1; unpack8(*(const u32x4*)(zr + Z_AB + c), b0, b1); unpack8(*(const u32x4*)(zr + Z_AG + c), g0, g1);
    acc0 = b0 * (acc0 + *(const f32x4*)(cb + c)) * silu4(g0); acc1 = b1 * (acc1 + *(const f32x4*)(cb + c + 4)) * silu4(g1);
    *(u32x4*)(Y + (size_t)t * DM + c) = pack8(acc0, acc1);
}
__device__ __forceinline__ void conv_branch(const Args& a, int li) {
    const bf16_t* Z = (const bf16_t*)(a.ws + WS_ZG); bf16_t* Y = (bf16_t*)(a.ws + WS_BUFY);
    const float* cw = a.in[I_CONVW] + (size_t)li * 3 * BW; const float* cb = a.in[I_CONVB] + (size_t)li * BW;
    const int N = MTOK * 32, stride = gridDim.x * NTHR, g0 = blockIdx.x * NTHR + opq(threadIdx.x);
    if (N % (4 * stride) == 0) { for (int base = g0; base < N; base += 4 * stride) {
#pragma unroll
        for (int q = 0; q < 4; ++q) conv_item(Z, Y, cw, cb, base + q * stride); } }
    else for (int idx = g0; idx < N; idx += stride) conv_item(Z, Y, cw, cb, idx);
}
__device__ __forceinline__ void qk_item(bf16_t* Z, const float* gq, const float* gk, int idx) {
    const int t = idx >> 5, h = (idx >> 3) & 3, l8 = idx & 7;
    bf16_t* qp = Z + (size_t)t * ZLD + Z_BQ + 64 * h + 8 * l8; bf16_t* kp = Z + (size_t)t * ZLD + Z_BK + 64 * h + 8 * l8;
    f32x4 q0, q1, k0, k1; unpack8(*(const u32x4*)qp, q0, q1); unpack8(*(const u32x4*)kp, k0, k1);
    float sq = (q0[0] * q0[0] + q0[1] * q0[1]) + (q0[2] * q0[2] + q0[3] * q0[3]) + (q1[0] * q1[0] + q1[1] * q1[1]) + (q1[2] * q1[2] + q1[3] * q1[3]);
    float sk = (k0[0] * k0[0] + k0[1] * k0[1]) + (k0[2] * k0[2] + k0[3] * k0[3]) + (k1[0] * k1[0] + k1[1] * k1[1]) + (k1[2] * k1[2] + k1[3] * k1[3]);
    sq = DPP_ADD(sq, 0xB1); sk = DPP_ADD(sk, 0xB1); sq = DPP_ADD(sq, 0x4E); sk = DPP_ADD(sk, 0x4E);
    sq += __shfl_xor(sq, 4); sk += __shfl_xor(sk, 4);
    const float rq = __builtin_amdgcn_rsqf(sq * (1.0f / HD) + EPS) * (0.125f * LOG2E), rk = __builtin_amdgcn_rsqf(sk * (1.0f / HD) + EPS);
    const f32x4 gq0 = *(const f32x4*)(gq + 8 * l8), gq1 = *(const f32x4*)(gq + 8 * l8 + 4), gk0 = *(const f32x4*)(gk + 8 * l8), gk1 = *(const f32x4*)(gk + 8 * l8 + 4);
    *(u32x4*)qp = pack8(q0 * gq0 * rq, q1 * gq1 * rq); *(u32x4*)kp = pack8(k0 * gk0 * rk, k1 * gk1 * rk);
}
__device__ __forceinline__ void qk_norm(const Args& a, int li) {
    bf16_t* Z = (bf16_t*)(a.ws + WS_ZG); const float* gq = a.in[I_QN] + li * HD; const float* gk = a.in[I_KN] + li * HD;
    const int N = MTOK * 32, stride = gridDim.x * NTHR, g0 = blockIdx.x * NTHR + opq(threadIdx.x);
    if (N % (4 * stride) == 0) { for (int base = g0; base < N; base += 4 * stride) {
#pragma unroll
        for (int q = 0; q < 4; ++q) qk_item(Z, gq, gk, base + q * stride); } }
    else for (int idx = g0; idx < N; idx += stride) qk_item(Z, gq, gk, idx);
}
__device__ __forceinline__ void v_transpose(const Args& a, unsigned char* lds) {
    const bf16_t* Z = (const bf16_t*)(a.ws + WS_ZG); bf16_t* VT = (bf16_t*)(a.ws + WS_VT);
    const int tid = opq(threadIdx.x); const int kv = tid >> 3, dg = tid & 7;
    int u = blockIdx.x, buf = 0;
    u32x4 reg = (u32x4){0u, 0u, 0u, 0u};
    if (u < 2048) { const int bh = u >> 7, tb = u & 127; reg = *(const u32x4*)(Z + (size_t)((bh >> 2) * SEQ + 64 * tb + kv) * ZLD + Z_BV + 64 * (bh & 3) + 8 * dg); }
    for (; u < 2048; u += gridDim.x) {
        bf16_t* tile = (bf16_t*)lds + buf * (64 * 72);
        const int bh = u >> 7, tb = u & 127;
        *(u32x4*)(tile + kv * 72 + 8 * dg) = reg;
        __syncthreads();
        const int un = u + gridDim.x;
        if (un < 2048) { const int bhn = un >> 7, tbn = un & 127; reg = *(const u32x4*)(Z + (size_t)((bhn >> 2) * SEQ + 64 * tbn + kv) * ZLD + Z_BV + 64 * (bhn & 3) + 8 * dg); }
        { const int d = tid >> 3, kg = tid & 7; unsigned w[4];
#pragma unroll
          for (int i = 0; i < 4; ++i) w[i] = (unsigned)tile[(8 * kg + 2 * i) * 72 + d] | ((unsigned)tile[(8 * kg + 2 * i + 1) * 72 + d] << 16);
          *(u32x4*)(VT + ((size_t)bh * 64 + d) * SEQ + 64 * tb + 8 * kg) = (u32x4){w[0], w[1], w[2], w[3]}; }
        buf ^= 1;
    }
    __syncthreads();
}
__device__ __forceinline__ void cum_local(const Args& a, int li, unsigned char* lds) {
    const float* flog = (const float*)(a.ws + WS_FLOG); float* cum = (float*)(a.ws + WS_CUM); float* btot = (float*)(a.ws + WS_BTOT);
    const f32x4 bias = *(const f32x4*)(a.in[I_FGB] + li * 4);
    const int tid = opq(threadIdx.x), lane = tid & 63, wid = tid >> 6; float* wt = (float*)lds;
    for (int u = blockIdx.x; u < 128; u += gridDim.x) {
        const size_t t = (size_t)u * 256 + (tid & 255);
        f32x4 v = *(const f32x4*)(flog + t * 4) + bias;
#pragma unroll
        for (int e = 0; e < 4; ++e) v[e] = fminf(v[e], 0.f) - log1pf(expf(-fabsf(v[e])));
#pragma unroll
        for (int o = 1; o < 64; o <<= 1) {
#pragma unroll
            for (int e = 0; e < 4; ++e) { const float n = __shfl_up(v[e], o); if (lane >= o) v[e] += n; } }
        if (lane == 63) *(f32x4*)(wt + wid * 4) = v;
        __syncthreads();
        if (tid < 256) {
            for (int w = 0; w < wid; ++w) v += *(const f32x4*)(wt + w * 4);
            *(f32x4*)(cum + t * 4) = v;
            if (tid == 255) *(f32x4*)(btot + u * 4) = v;
        }
        __syncthreads();
    }
}
__device__ __forceinline__ float hgrn_lb(const float* lbl, int li, int ch) {
    const float l0 = lbl[ch], l1 = lbl[BW + ch], l2 = lbl[2 * BW + ch], l3 = lbl[3 * BW + ch];
    const float mx = fmaxf(fmaxf(l0, l1), fmaxf(l2, l3));
    const float e0 = expf(l0 - mx), e1 = expf(l1 - mx), e2 = expf(l2 - mx), e3 = expf(l3 - mx), inv = 1.0f / (e0 + e1 + e2 + e3);
    float acc = 0.f; if (li >= 1) acc += e1 * inv; if (li >= 2) acc += e2 * inv; if (li >= 3) acc += e3 * inv;
    return fminf(fmaxf(acc, 0.f), 1.f);
}
__device__ __forceinline__ void hgrn_local(const Args& a, int li, unsigned char* lds) {
    const bf16_t* Z = (const bf16_t*)(a.ws + WS_ZG); float* U = (float*)(a.ws + WS_U); float* dvec = (float*)(a.ws + WS_DVEC);
    const int tid = opq(threadIdx.x), lane = tid & 63, wave = tid >> 6, kg = lane & 3, vg = lane >> 2;
    float* wl = (float*)(lds + wave * 10240);
    for (int u = blockIdx.x * NWAVES + wave; u < 2048; u += gridDim.x * NWAVES) {
        const int bh = u >> 7, ch = u & 127, b = bh >> 2, h = bh & 3; const size_t row0 = (size_t)b * SEQ + 64 * ch;
        const float lb = hgrn_lb(a.in[I_LB], li, 64 * h + lane);
        f32x2 S[8][4];
#pragma unroll
        for (int kp = 0; kp < 8; ++kp)
#pragma unroll
            for (int vv = 0; vv < 4; ++vv) S[kp][vv] = (f32x2){0.f, 0.f};
        float dprod = 1.f;
        const bf16_t* zb = Z + row0 * ZLD + 64 * h + lane;
        bf16_t rf[8], ri[8];
#pragma unroll
        for (int j = 0; j < 8; ++j) { rf[j] = zb[(size_t)j * ZLD + Z_CF]; ri[j] = zb[(size_t)j * ZLD + Z_CI]; }
        for (int tb = 0; tb < 8; ++tb) {
            asm volatile("" ::: "memory");
#pragma unroll
            for (int j = 0; j < 8; ++j) { const float f = bflo(rf[j]), vi = bflo(ri[j]);
                const float sg = sigm(f), g = lb + (1.f - lb) * sg; dprod *= g;
                wl[(j * 3 + 0) * 64 + lane] = g; wl[(j * 3 + 1) * 64 + lane] = (1.f - lb) * (1.f - sg); wl[(j * 3 + 2) * 64 + lane] = vi; }
            if (tb < 7) {
#pragma unroll
                for (int j = 0; j < 8; ++j) { rf[j] = zb[(size_t)(8 * (tb + 1) + j) * ZLD + Z_CF]; ri[j] = zb[(size_t)(8 * (tb + 1) + j) * ZLD + Z_CI]; } }
            asm volatile("" ::: "memory");
#pragma unroll
            for (int j = 0; j < 8; ++j) { f32x4 g4[4], kf4[4];
#pragma unroll
                for (int i = 0; i < 4; ++i) { g4[i] = *(const f32x4*)(wl + (j * 3 + 0) * 64 + 16 * kg + 4 * i); kf4[i] = *(const f32x4*)(wl + (j * 3 + 1) * 64 + 16 * kg + 4 * i); }
                const f32x4 v4 = *(const f32x4*)(wl + (j * 3 + 2) * 64 + 4 * vg);
#pragma unroll
                for (int vv = 0; vv < 4; ++vv) { const f32x2 vvv = (f32x2){v4[vv], v4[vv]};
#pragma unroll
                    for (int kp = 0; kp < 8; ++kp) { const f32x2 gp = (f32x2){g4[kp >> 1][2 * (kp & 1)], g4[kp >> 1][2 * (kp & 1) + 1]}, kfp = (f32x2){kf4[kp >> 1][2 * (kp & 1)], kf4[kp >> 1][2 * (kp & 1) + 1]};
                        S[kp][vv] = gp * S[kp][vv] + kfp * vvv; } } }
        }
        float* up = U + (size_t)u * 4096 + 4 * vg;
#pragma unroll
        for (int kp = 0; kp < 8; ++kp)
#pragma unroll
            for (int e = 0; e < 2; ++e) *(f32x4*)(up + (16 * kg + 2 * kp + e) * 64) = (f32x4){S[kp][0][e], S[kp][1][e], S[kp][2][e], S[kp][3][e]};
        dvec[(size_t)u * 64 + lane] = dprod;
    }
    __syncthreads();
}
__device__ __forceinline__ void spatial_branch(const Args& a, int li, unsigned char* lds) {
    const bf16_t* Z = (const bf16_t*)(a.ws + WS_ZG); bf16_t* Y = (bf16_t*)(a.ws + WS_BUFY);
    bf16_t* WB = (bf16_t*)lds; bf16_t* VT = (bf16_t*)(lds + 34816);
    const int tid = opq(threadIdx.x), lane = tid & 63, wid = tid >> 6, r32 = lane & 31, hi = lane >> 5;
    int gloaded = -1;
    for (int u = blockIdx.x; u < 1024; u += gridDim.x) {
        const int ci = u >> 2, g = u & 3; const size_t row0 = (size_t)ci * 128;
        const float* gv = a.in[I_SGN] + li * BW + 64 * g;
        if (g != gloaded) { const float* wsrc = a.in[I_SPW] + ((size_t)li * NH + g) * 128 * 128; gloaded = g;
#pragma unroll
            for (int i = 0; i < 4; ++i) { const int e8 = i * NTHR + tid, t = e8 >> 4, s0 = (e8 & 15) * 8;
                f32x4 w0 = *(const f32x4*)(wsrc + t * 128 + s0), w1 = *(const f32x4*)(wsrc + t * 128 + s0 + 4);
#pragma unroll
                for (int j = 0; j < 4; ++j) { if (s0 + j > t) w0[j] = 0.f; if (s0 + 4 + j > t) w1[j] = 0.f; }
                *(u32x4*)(WB + t * 136 + s0) = pack8(w0, w1); } }
#pragma unroll
        for (int pass = 0; pass < 2; ++pass) { const int r = (tid >> 3) + 64 * pass, l8 = tid & 7;
            f32x4 v0, v1; unpack8(*(const u32x4*)(Z + (row0 + r) * ZLD + Z_DV + 64 * g + 8 * l8), v0, v1);
            float ss = (v0[0] * v0[0] + v0[1] * v0[1]) + (v0[2] * v0[2] + v0[3] * v0[3]) + (v1[0] * v1[0] + v1[1] * v1[1]) + (v1[2] * v1[2] + v1[3] * v1[3]);
#pragma unroll
            for (int o = 1; o < 8; o <<= 1) ss += __shfl_xor(ss, o);
            const float rstd = 1.0f / sqrtf(ss * (1.0f / HD) + EPS);
            v0 = v0 * rstd * *(const f32x4*)(gv + 8 * l8); v1 = v1 * rstd * *(const f32x4*)(gv + 8 * l8 + 4);
#pragma unroll
            for (int j = 0; j < 4; ++j) { VT[(8 * l8 + j) * 136 + r] = (bf16_t)f2bf(v0[j]); VT[(8 * l8 + 4 + j) * 136 + r] = (bf16_t)f2bf(v1[j]); } }
        __syncthreads();
        { const int tb = wid >> 1, cb = wid & 1;
          f32x16 acc;
#pragma unroll
          for (int r = 0; r < 16; ++r) acc[r] = 0.f;
          const bf16_t* ap = VT + (32 * cb + r32) * 136 + 8 * hi; const bf16_t* bp = WB + (32 * tb + r32) * 136 + 8 * hi;
          for (int ks = 0; ks < 2 * (tb + 1); ++ks) acc = __builtin_amdgcn_mfma_f32_32x32x16_bf16(*(const bf16x8*)(ap + 16 * ks), *(const bf16x8*)(bp + 16 * ks), acc, 0, 0, 0);
          const int t = 32 * tb + r32; const float bs = a.in[I_SPB][((size_t)li * NH + g) * 128 + t];
#pragma unroll
          for (int rr = 0; rr < 4; ++rr) { const int c0 = 32 * cb + 8 * rr + 4 * hi;
              const bf16_t* zr = Z + (row0 + t) * ZLD + 64 * g + c0; const u32x2 uw = *(const u32x2*)(zr + Z_DU), gw = *(const u32x2*)(zr + Z_DG);
              const float o0 = bflo(uw.x) * (acc[4 * rr + 0] + bs) * silu(bflo(gw.x)), o1 = bfhi(uw.x) * (acc[4 * rr + 1] + bs) * silu(bfhi(gw.x)),
                          o2 = bflo(uw.y) * (acc[4 * rr + 2] + bs) * silu(bflo(gw.y)), o3 = bfhi(uw.y) * (acc[4 * rr + 3] + bs) * silu(bfhi(gw.y));
              *(u32x2*)(Y + (row0 + t) * DM + 768 + 64 * g + c0) = (u32x2){pk2(o0, o1), pk2(o2, o3)}; } }
        __syncthreads();
    }
}
__device__ __forceinline__ void hgrn_scan(const Args& a, int unit) {
    float* U = (float*)(a.ws + WS_U); const float* dvec = (const float*)(a.ws + WS_DVEC);
    const int bh = unit >> 3, e = (unit & 7) * 512 + opq(threadIdx.x), k = e >> 6;
    float st = 0.f;
    for (int c0 = 0; c0 < 128; c0 += 32) { float uv[32], dv[32];
#pragma unroll
        for (int j = 0; j < 32; ++j) { uv[j] = U[((size_t)(bh * 128 + c0 + j)) * 4096 + e]; dv[j] = dvec[(size_t)(bh * 128 + c0 + j) * 64 + k]; }
#pragma unroll
        for (int j = 0; j < 32; ++j) { U[((size_t)(bh * 128 + c0 + j)) * 4096 + e] = st; st = dv[j] * st + uv[j]; } }
}
__device__ __forceinline__ int pi32(int m) { return (m & 19) | ((m >> 1) & 4) | ((m << 1) & 8); }
__device__ __forceinline__ void attn_unit(const Args& a, int li, unsigned char* lds, int b, int h, int qb) {
    const bf16_t* Z = (const bf16_t*)(a.ws + WS_ZG); const bf16_t* VT = (const bf16_t*)(a.ws + WS_VT); bf16_t* Y = (bf16_t*)(a.ws + WS_BUFY);
    const float* cum = (const float*)(a.ws + WS_CUM); const float* btot = (const float*)(a.ws + WS_BTOT);
    unsigned char* Ks = lds; unsigned char* Vs = lds + 18432; float* cks = (float*)(lds + 36864); float* offs = (float*)(lds + 37376); float* tmp = (float*)(lds + 37504);
    float* thrp = (float*)(lds + 37632); int* cntp = (int*)(lds + 37636);
    float* xfl = (float*)(lds + 37664); float* wmin = (float*)(lds + 37696); float* cend2 = (float*)(lds + 37760);
    const int tid = opq(threadIdx.x), lane = tid & 63, wid = tid >> 6, r32 = lane & 31, hi = lane >> 5;
    const size_t rowb = (size_t)b * SEQ; const int t0 = 256 * qb, bh = b * 4 + h;
    if (tid < 32) tmp[tid] = btot[(b * 32 + tid) * 4 + h];
    if (wid == 1) { float mq = fabsf(a.in[I_QN][li * HD + lane]), mk = fabsf(a.in[I_KN][li * HD + lane]);
#pragma unroll
        for (int o = 1; o < 64; o <<= 1) { mq = fmaxf(mq, __shfl_xor(mq, o)); mk = fmaxf(mk, __shfl_xor(mk, o)); }
        if (lane == 0) { *thrp = 32.0f + 2.0f * 1.02f * 8.0f * mq * mk; *cntp = 0; xfl[0] = 1.02f * 8.0f * mq * mk * LOG2E; }
        if (lane < 16) wmin[lane] = -1e30f; }
    __syncthreads();
    if (tid == 0) { float run = 0.f; for (int i = 0; i < 32; ++i) { offs[i] = run; run += tmp[i]; } }
    __syncthreads();
    { const float cq0 = offs[qb] + cum[(rowb + t0) * 4 + h];
      if (tid == 0) xfl[1] = cq0 * LOG2E;
      if (tid < 4 * qb) { const int tl = 64 * tid + 63; const float cl = offs[tl >> 8] + cum[(rowb + tl) * 4 + h]; cend2[tid] = cl * LOG2E; if (cq0 - cl < -(*thrp)) atomicAdd(cntp, 1); } }
    __syncthreads();
    const int jstart = *cntp, jend = 4 * qb + 3;
    const int tq = t0 + 32 * wid + r32;
    const float cq2 = (offs[qb] + cum[(rowb + tq) * 4 + h]) * LOG2E;
    bf16x8 qr[4];
#pragma unroll
    for (int d0 = 0; d0 < 4; ++d0) qr[d0] = *(const bf16x8*)(Z + (rowb + tq) * ZLD + Z_BQ + 64 * h + 16 * d0 + 8 * hi);
    f32x16 o0, o1;
#pragma unroll
    for (int r = 0; r < 16; ++r) { o0[r] = 0.f; o1[r] = 0.f; }
    float mrun = -1e30f, lrun = 0.f;
    const int srow = tid >> 3, sc8 = tid & 7;
    const bf16_t* kgp = Z + (rowb + srow) * ZLD + Z_BK + 64 * h + 8 * sc8;
    const bf16_t* vgp = VT + ((size_t)bh * 64 + srow) * SEQ + 8 * sc8;
    const int krow = pi32(r32);
    u32x4 kA = *(const u32x4*)(kgp + (size_t)(64 * jend) * ZLD), vA = *(const u32x4*)(vgp + 64 * jend), kB = kA, vB = vA;
    float cA = 0.f, cB = 0.f;
    if (tid < 64) { const int t = 64 * jend + tid; cA = -(offs[t >> 8] + cum[(rowb + t) * 4 + h]) * LOG2E; }
    if (jend - 1 >= jstart) { kB = *(const u32x4*)(kgp + (size_t)(64 * (jend - 1)) * ZLD); vB = *(const u32x4*)(vgp + 64 * (jend - 1));
        if (tid < 64) { const int t = 64 * (jend - 1) + tid; cB = -(offs[t >> 8] + cum[(rowb + t) * 4 + h]) * LOG2E; } }
    const float qkb2 = xfl[0], cq02 = xfl[1];
    bool stop = false; int par = 0;
#define ATT_STEP(KR, VR, CR, JT, BUF) do { const int jt_ = (JT); \
        unsigned char* Kb = Ks + (BUF) * 9216; unsigned char* Vb = Vs + (BUF) * 9216; float* cb = cks + (BUF) * 64; \
        *(u32x4*)(Kb + srow * 144 + sc8 * 16) = KR; *(u32x4*)(Vb + srow * 144 + sc8 * 16) = VR; if (tid < 64) cb[tid] = CR; \
        __syncthreads(); \
        { const float* wm = wmin + 8 * (par ^ 1); const float mmin = fminf(fminf(fminf(wm[0], wm[1]), fminf(wm[2], wm[3])), fminf(fminf(wm[4], wm[5]), fminf(wm[6], wm[7]))); \
          const int jn = jt_ - 1; stop = (jn >= jstart) && (jn < 4 * qb) && (qkb2 + cq02 - cend2[jn < 0 ? 0 : jn] < mmin - 32.0f * LOG2E); } \
        if (jt_ - 2 >= jstart) { KR = *(const u32x4*)(kgp + (size_t)(64 * (jt_ - 2)) * ZLD); VR = *(const u32x4*)(vgp + 64 * (jt_ - 2)); \
            if (tid < 64) { const int t = 64 * (jt_ - 2) + tid; CR = -(offs[t >> 8] + cum[(rowb + t) * 4 + h]) * LOG2E; } } \
        const int tile_lo = 64 * jt_, wq_lo = t0 + 32 * wid; \
        if (tile_lo <= wq_lo + 31) { \
            f32x16 p0, p1; \
            _Pragma("unroll") for (int r = 0; r < 16; ++r) { p0[r] = cq2; p1[r] = cq2; } \
            _Pragma("unroll") for (int d0 = 0; d0 < 4; ++d0) { \
                const bf16x8 k0 = *(const bf16x8*)(Kb + krow * 144 + 32 * d0 + 16 * hi), k1 = *(const bf16x8*)(Kb + (32 + krow) * 144 + 32 * d0 + 16 * hi); \
                p0 = __builtin_amdgcn_mfma_f32_32x32x16_bf16(k0, qr[d0], p0, 0, 0, 0); p1 = __builtin_amdgcn_mfma_f32_32x32x16_bf16(k1, qr[d0], p1, 0, 0, 0); } \
            const bool need_mask = (tile_lo + 63 > wq_lo); \
            float rm = -1e30f; \
            _Pragma("unroll") for (int g = 0; g < 4; ++g) { \
                const int kv0 = 32 * (g >> 1) + 16 * (g & 1) + 8 * hi; const f32x4 c0 = *(const f32x4*)(cb + kv0), c1 = *(const f32x4*)(cb + kv0 + 4); \
                _Pragma("unroll") for (int e = 0; e < 8; ++e) { const float ck = e < 4 ? c0[e & 3] : c1[e & 3]; const int r = (g & 1) * 8 + e; \
                    float s = (g < 2 ? p0[r] : p1[r]) + ck; \
                    if (need_mask && (tile_lo + kv0 + e > tq)) s = -1e30f; \
                    if (g < 2) p0[r] = s; else p1[r] = s; rm = fmaxf(rm, s); } } \
            rm = fmaxf(rm, __shfl_xor(rm, 32)); \
            const float mnew = fmaxf(mrun, rm); \
            if (__any(rm > mrun)) { const float alpha = __builtin_amdgcn_exp2f(mrun - mnew); lrun *= alpha; \
                _Pragma("unroll") for (int r = 0; r < 16; ++r) { o0[r] *= alpha; o1[r] *= alpha; } } \
            mrun = mnew; \
            float ls = 0.f; \
            _Pragma("unroll") for (int r = 0; r < 16; ++r) { p0[r] = __builtin_amdgcn_exp2f(p0[r] - mnew); p1[r] = __builtin_amdgcn_exp2f(p1[r] - mnew); ls += p0[r] + p1[r]; } \
            lrun += ls; \
            bf16x8 pa[4]; \
            _Pragma("unroll") for (int j = 0; j < 4; ++j) { u32x4 w; \
                if (j < 2) { w.x = pk2(p0[8 * (j & 1) + 0], p0[8 * (j & 1) + 1]); w.y = pk2(p0[8 * (j & 1) + 2], p0[8 * (j & 1) + 3]); w.z = pk2(p0[8 * (j & 1) + 4], p0[8 * (j & 1) + 5]); w.w = pk2(p0[8 * (j & 1) + 6], p0[8 * (j & 1) + 7]); } \
                else { w.x = pk2(p1[8 * (j & 1) + 0], p1[8 * (j & 1) + 1]); w.y = pk2(p1[8 * (j & 1) + 2], p1[8 * (j & 1) + 3]); w.z = pk2(p1[8 * (j & 1) + 4], p1[8 * (j & 1) + 5]); w.w = pk2(p1[8 * (j & 1) + 6], p1[8 * (j & 1) + 7]); } \
                pa[j] = __builtin_bit_cast(bf16x8, w); } \
            _Pragma("unroll") for (int j = 0; j < 4; ++j) { \
                const bf16x8 v0 = *(const bf16x8*)(Vb + r32 * 144 + (16 * j + 8 * hi) * 2), v1 = *(const bf16x8*)(Vb + (32 + r32) * 144 + (16 * j + 8 * hi) * 2); \
                o0 = __builtin_amdgcn_mfma_f32_32x32x16_bf16(v0, pa[j], o0, 0, 0, 0); o1 = __builtin_amdgcn_mfma_f32_32x32x16_bf16(v1, pa[j], o1, 0, 0, 0); } \
        } \
        { float wm_ = mrun; _Pragma("unroll") for (int o_ = 1; o_ < 32; o_ <<= 1) wm_ = fminf(wm_, __shfl_xor(wm_, o_)); if (lane == 0) wmin[8 * par + wid] = wm_; } \
        par ^= 1; } while (0)
    for (int jt = jend; jt >= jstart; jt -= 2) {
        ATT_STEP(kA, vA, cA, jt, 0);
        if (jt - 1 < jstart || stop) break;
        ATT_STEP(kB, vB, cB, jt - 1, 1);
        if (stop) break;
    }
#undef ATT_STEP
    lrun += __shfl_xor(lrun, 32);
    const float rl = 1.0f / lrun;
    const bf16_t* zg = Z + (rowb + tq) * ZLD + Z_BG + 64 * h; bf16_t* yr = Y + (rowb + tq) * DM + 256 + 64 * h;
#pragma unroll
    for (int dh = 0; dh < 2; ++dh)
#pragma unroll
        for (int rr = 0; rr < 4; ++rr) { const int d = 32 * dh + 8 * rr + 4 * hi; const u32x2 gw = *(const u32x2*)(zg + d);
            const float g0 = silu(bflo(gw.x)), g1 = silu(bfhi(gw.x)), g2 = silu(bflo(gw.y)), g3 = silu(bfhi(gw.y));
            const float v0 = (dh ? o1[4 * rr + 0] : o0[4 * rr + 0]) * rl * g0, v1 = (dh ? o1[4 * rr + 1] : o0[4 * rr + 1]) * rl * g1,
                        v2 = (dh ? o1[4 * rr + 2] : o0[4 * rr + 2]) * rl * g2, v3 = (dh ? o1[4 * rr + 3] : o0[4 * rr + 3]) * rl * g3;
            *(u32x2*)(yr + d) = (u32x2){pk2(v0, v1), pk2(v2, v3)}; }
    __syncthreads();
}
__device__ __forceinline__ void hgrn_out(const Args& a, int li, unsigned char* lds) {
    const bf16_t* Z = (const bf16_t*)(a.ws + WS_ZG); const float* U = (const float*)(a.ws + WS_U); bf16_t* Y = (bf16_t*)(a.ws + WS_BUFY);
    const int tid = opq(threadIdx.x), lane = tid & 63, wave = tid >> 6, kg = lane & 3, vg = lane >> 2;
    float* wl = (float*)(lds + wave * 10240);
    for (int u = blockIdx.x * NWAVES + wave; u < 2048; u += gridDim.x * NWAVES) {
        const int bh = u >> 7, ch = u & 127, b = bh >> 2, h = bh & 3; const size_t row0 = (size_t)b * SEQ + 64 * ch;
        const float lb = hgrn_lb(a.in[I_LB], li, 64 * h + lane);
        const float gain = a.in[I_HGN][li * BW + 64 * h + lane];
        const bf16_t* zb = Z + row0 * ZLD + 64 * h + lane;
        bf16_t rq[8], rf[8], ri[8], rg[8];
#pragma unroll
        for (int j = 0; j < 8; ++j) { rq[j] = zb[(size_t)j * ZLD + Z_CQ]; rf[j] = zb[(size_t)j * ZLD + Z_CF]; ri[j] = zb[(size_t)j * ZLD + Z_CI]; rg[j] = zb[(size_t)j * ZLD + Z_CG]; }
        f32x2 S[8][4];
        { const float* up = U + (size_t)u * 4096 + 4 * vg;
#pragma unroll
          for (int kp = 0; kp < 8; ++kp) { const f32x4 r0 = *(const f32x4*)(up + (16 * kg + 2 * kp) * 64), r1 = *(const f32x4*)(up + (16 * kg + 2 * kp + 1) * 64);
#pragma unroll
              for (int vv = 0; vv < 4; ++vv) S[kp][vv] = (f32x2){r0[vv], r1[vv]}; } }
        for (int tb = 0; tb < 8; ++tb) {
            asm volatile("" ::: "memory");
#pragma unroll
            for (int j = 0; j < 8; ++j) { const float q = bflo(rq[j]), f = bflo(rf[j]), vi = bflo(ri[j]), gt = bflo(rg[j]);
                const float sg = sigm(f);
                wl[(j * 5 + 0) * 64 + lane] = lb + (1.f - lb) * sg; wl[(j * 5 + 1) * 64 + lane] = (1.f - lb) * (1.f - sg); wl[(j * 5 + 2) * 64 + lane] = silu(q);
                wl[(j * 5 + 3) * 64 + lane] = vi; wl[(j * 5 + 4) * 64 + lane] = silu(gt) * gain; }
            if (tb < 7) {
#pragma unroll
                for (int j = 0; j < 8; ++j) { const size_t o = (size_t)(8 * (tb + 1) + j) * ZLD; rq[j] = zb[o + Z_CQ]; rf[j] = zb[o + Z_CF]; ri[j] = zb[o + Z_CI]; rg[j] = zb[o + Z_CG]; } }
            asm volatile("" ::: "memory");
#pragma unroll
            for (int j = 0; j < 8; ++j) { f32x4 g4[4], kf4[4], q4[4];
#pragma unroll
                for (int i = 0; i < 4; ++i) { g4[i] = *(const f32x4*)(wl + (j * 5 + 0) * 64 + 16 * kg + 4 * i); kf4[i] = *(const f32x4*)(wl + (j * 5 + 1) * 64 + 16 * kg + 4 * i); q4[i] = *(const f32x4*)(wl + (j * 5 + 2) * 64 + 16 * kg + 4 * i); }
                const f32x4 v4 = *(const f32x4*)(wl + (j * 5 + 3) * 64 + 4 * vg), gt4 = *(const f32x4*)(wl + (j * 5 + 4) * 64 + 4 * vg);
                f32x4 o;
#pragma unroll
                for (int vv = 0; vv < 4; ++vv) { const f32x2 vvv = (f32x2){v4[vv], v4[vv]}; f32x2 o2 = (f32x2){0.f, 0.f};
#pragma unroll
                    for (int kp = 0; kp < 8; ++kp) { const f32x2 gp = (f32x2){g4[kp >> 1][2 * (kp & 1)], g4[kp >> 1][2 * (kp & 1) + 1]}, kfp = (f32x2){kf4[kp >> 1][2 * (kp & 1)], kf4[kp >> 1][2 * (kp & 1) + 1]},
                                                                qp = (f32x2){q4[kp >> 1][2 * (kp & 1)], q4[kp >> 1][2 * (kp & 1) + 1]};
                        S[kp][vv] = gp * S[kp][vv] + kfp * vvv; o2 += qp * S[kp][vv]; }
                    float ov = o2[0] + o2[1]; ov = DPP_ADD(ov, 0xB1); ov = DPP_ADD(ov, 0x4E); o[vv] = ov; }
                float ss = (o[0] * o[0] + o[1] * o[1]) + (o[2] * o[2] + o[3] * o[3]);
                ss = DPP_ADD(ss, 0x124); ss = DPP_ADD(ss, 0x128);
                ss += __shfl_xor(ss, 16); ss += __shfl_xor(ss, 32);
                const float rstd = __builtin_amdgcn_rsqf(ss * (1.0f / HD) + EPS);
                if (kg == 0) *(u32x2*)(Y + (row0 + 8 * tb + j) * DM + 512 + 64 * h + 4 * vg) = (u32x2){pk2(o[0] * rstd * gt4[0], o[1] * rstd * gt4[1]), pk2(o[2] * rstd * gt4[2], o[3] * rstd * gt4[3])}; }
        }
    }
    __syncthreads();
}

#define XB_TMO      128
#define XB_XCNT(j)  (256  + 64 * (j))
#define XB_XSUB(j)  (1280 + 64 * (j))
#define XB_XGEN(j)  (2304 + 64 * (j))
#define XB_TOP      3328
#define XB_TOPGEN   3392
#define XCD_BAR_WORDS 3456
#define XB_SPIN_CAP (1u << 18)
__device__ __forceinline__ unsigned xb_ld(unsigned* p)              { return __hip_atomic_load(p, __ATOMIC_RELAXED, __HIP_MEMORY_SCOPE_AGENT); }
__device__ __forceinline__ unsigned xb_add(unsigned* p, unsigned v) { return __hip_atomic_fetch_add(p, v, __ATOMIC_RELAXED, __HIP_MEMORY_SCOPE_AGENT); }
__device__ __forceinline__ unsigned xb_xcc_id() { return (unsigned)__builtin_amdgcn_s_getreg((3 << 11) | 20) & 0xFu; }
#define XB_SPIN(cond, bar) do { unsigned _sp = 0; while (cond) { __builtin_amdgcn_s_sleep(1); \
    if ((++_sp & 255u) == 0u) { if (xb_ld(&(bar)[XB_TMO])) break; if (_sp > XB_SPIN_CAP) { atomicAdd(&(bar)[XB_TMO], 1u); break; } } } } while (0)
struct XcdBarrier { unsigned* bar; unsigned x; volatile LAS unsigned* st; };
__device__ __forceinline__ XcdBarrier xcd_barrier_post(unsigned* bar, volatile LAS unsigned* st) {
    XcdBarrier b; b.bar = bar; b.x = xb_xcc_id(); b.st = st;
    if (threadIdx.x == 0) (void)xb_add(&bar[XB_XCNT(b.x)], 1u);
    return b;
}
__device__ __forceinline__ void xcd_barrier_complete(unsigned* bar, unsigned x, unsigned& nloc, unsigned& nx) {
    const unsigned G = gridDim.x * gridDim.y * gridDim.z;
    unsigned sum, cnt, mine, sp = 0u;
    for (;;) {
        sum = 0u; cnt = 0u; mine = 0u;
#pragma unroll
        for (unsigned j = 0; j < 16; ++j) { const unsigned c = xb_ld(&bar[XB_XCNT(j)]); sum += c; cnt += (c > 0u) ? 1u : 0u; mine = (j == x) ? c : mine; }
        if (sum == G) break;
        __builtin_amdgcn_s_sleep(1);
        if ((++sp & 255u) == 0u) { if (xb_ld(&bar[XB_TMO])) break; if (sp > XB_SPIN_CAP) { atomicAdd(&bar[XB_TMO], 1u); break; } }
    }
    nloc = mine > 0u ? mine : 1u; nx = cnt > 0u ? cnt : 1u;
}
__device__ __forceinline__ void xcd_barrier(const XcdBarrier& b) {
    asm volatile("s_waitcnt vmcnt(0)" ::: "memory");
    __syncthreads();
    if (threadIdx.x == 0) {
        unsigned* bar = b.bar;
        __builtin_amdgcn_s_waitcnt(0);
        unsigned nloc = b.st[0], nx = b.st[1];
        if (nloc == 0u) { xcd_barrier_complete(bar, b.x, nloc, nx); b.st[0] = nloc; b.st[1] = nx; }
        const unsigned old = xb_add(&bar[XB_XSUB(b.x)], 1u);
        const unsigned gen = old / nloc;
        if (old + 1u == (gen + 1u) * nloc) {
            __builtin_amdgcn_fence(__ATOMIC_RELEASE, "agent");
            asm volatile("s_waitcnt vmcnt(0)" ::: "memory");
            const unsigned og = xb_add(&bar[XB_TOP], 1u);
            const unsigned tg = og / nx;
            if (og + 1u == (tg + 1u) * nx) xb_add(&bar[XB_TOPGEN], 1u);
            else XB_SPIN(xb_ld(&bar[XB_TOPGEN]) == tg, bar);
            __builtin_amdgcn_fence(__ATOMIC_ACQUIRE, "agent");
            xb_add(&bar[XB_XGEN(b.x)], 1u);
            asm volatile("s_waitcnt vmcnt(0)" ::: "memory");
        } else {
            XB_SPIN(xb_ld(&bar[XB_XGEN(b.x)]) == gen, bar);
            __builtin_amdgcn_fence(__ATOMIC_ACQUIRE, "agent");
            asm volatile("s_waitcnt vmcnt(0)" ::: "memory");
        }
    }
    __syncthreads();
}

#ifndef PHM
#define PHM 0xFFFF
#endif
#define PH(b) ((PHM >> (b)) & 1)
#ifndef REP_P1
#define REP_P1 1
#endif
#ifndef REP_SYNC
#define REP_SYNC 0
#endif
#ifndef REP_ATT
#define REP_ATT 1
#endif
#ifndef REP_HO
#define REP_HO 1
#endif
#ifndef REP_P2A
#define REP_P2A 1
#endif
#ifndef REP_P3A
#define REP_P3A 1
#endif
#ifndef REP_P3B
#define REP_P3B 1
#endif
__global__ void __launch_bounds__(NTHR, 2) mega_fwd(Args a) {
    extern __shared__ __attribute__((aligned(16))) unsigned char lds_raw[];
    cg::grid_group grid = cg::this_grid();
    LAS unsigned char* ldsl = (LAS unsigned char*)lds_raw;
    const int tid = threadIdx.x, lane = tid & 63, wave = tid >> 6;
    const int G = gridDim.x, bx = blockIdx.x;
    unsigned char* ws = a.ws;
    bf16_t* WIN = (bf16_t*)(ws + WS_WIN); bf16_t* BUFH = (bf16_t*)(ws + WS_BUFH); bf16_t* BUFY = (bf16_t*)(ws + WS_BUFY); bf16_t* ZG = (bf16_t*)(ws + WS_ZG);
    float* SSA = (float*)(ws + WS_SSA); float* SSB = (float*)(ws + WS_SSB);
    float* scr = (float*)(lds_raw + wave * 16384);
    const int gw = bx * NWAVES + wave, NGW = G * NWAVES;
    if (tid < 2) ((volatile LAS unsigned*)(ldsl + 131072 + 128))[tid] = 0u;
    __syncthreads();
    const XcdBarrier xbar = xcd_barrier_post((unsigned*)ws, (volatile LAS unsigned*)(ldsl + 131072 + 128));
#define GSYNC() xcd_barrier(xbar)

    if (PH(0)) {
    for (int it = gw; it < 6656; it += NGW) convert_small_item(a, it, scr, lane);
    for (int it = gw; it < 4096; it += NGW) convert_win_item(a, 0, it, scr, lane);
    convert_p(a, 0);
    for (int m = gw; m < MTOK; m += NGW) {
        const f32x4* xr = (const f32x4*)(a.in[I_X] + (size_t)m * DM) + lane; const f32x4* gr = (const f32x4*)a.in[I_NMIX] + lane; float s = 0.f;
        u32x2* o8 = (u32x2*)(BUFH + (size_t)m * DM) + lane;
#pragma unroll
        for (int j = 0; j < 4; ++j) { const f32x4 v = xr[64 * j], gg = gr[64 * j]; s += (v[0] * v[0] + v[1] * v[1]) + (v[2] * v[2] + v[3] * v[3]);
            o8[64 * j] = (u32x2){pk2(v[0] * gg[0], v[1] * gg[1]), pk2(v[2] * gg[2], v[3] * gg[3])}; }
#pragma unroll
        for (int o = 1; o < 64; o <<= 1) s += __shfl_xor(s, o);
        if (lane < 16) SSA[(size_t)lane * MTOK + m] = lane == 0 ? s : 0.f;
    }
    }
    grid.sync();

    for (int li = 0; li < DEPTH; ++li) {
        for (int rep = 0; rep < REP_P1; ++rep) if (PH(1)) { pg8::Gemm g{BUFH, WIN, DM, DM, DM, 0, 0}; pg8::StaticOrder S; S.init(MTOK, 4096, G, bx);
          pg8::stage_rstd(SSA, S, lds_raw);
          pg8::EpiZ E{ZG, (float*)(ws + WS_FLOG), SSA, lds_raw};
          pg8::gemm_phase(ldsl, g, S, E); }
        GSYNC();
        for (int rep = 0; rep < REP_P2A; ++rep) {
        if (PH(2)) conv_branch(a, li);
        if (PH(3) && rep == 0) qk_norm(a, li);
        if (PH(4)) v_transpose(a, lds_raw);
        if (PH(5)) cum_local(a, li, lds_raw);
        if (PH(6)) hgrn_local(a, li, lds_raw);
        if (PH(7)) spatial_branch(a, li, lds_raw);
        }
        GSYNC();
        if (PH(8)) if (bx >= G - 128) { hgrn_scan(a, bx - (G - 128));
            asm volatile("s_waitcnt vmcnt(0)" ::: "memory"); __syncthreads();
            if (threadIdx.x == 0) { __builtin_amdgcn_fence(__ATOMIC_RELEASE, "agent"); asm volatile("s_waitcnt vmcnt(0)" ::: "memory");
                __hip_atomic_fetch_add((unsigned*)(ws + 45056) + li * 64, 1u, __ATOMIC_RELAXED, __HIP_MEMORY_SCOPE_AGENT); } }
        if (PH(9)) {
            unsigned* qctr = (unsigned*)(ws + 32768) + li * 64; int* qslot = (int*)(lds_raw + 37640);
            for (;;) {
                if (threadIdx.x == 0) *qslot = (int)__hip_atomic_fetch_add(qctr, 1u, __ATOMIC_RELAXED, __HIP_MEMORY_SCOPE_AGENT);
                __syncthreads();
                const int q = *qslot;
                __syncthreads();
                if (q >= 512) break;
                attn_unit(a, li, lds_raw, q & 3, 3 - (q >> 7), 31 - ((q & 127) >> 2));
            }
        }
        if (threadIdx.x == 0) { unsigned* fl = (unsigned*)(ws + 45056) + li * 64; unsigned sp = 0u;
            while (__hip_atomic_load(fl, __ATOMIC_RELAXED, __HIP_MEMORY_SCOPE_AGENT) < 128u) { __builtin_amdgcn_s_sleep(2); if (++sp > (1u << 22)) break; }
            __builtin_amdgcn_fence(__ATOMIC_ACQUIRE, "agent"); asm volatile("s_waitcnt vmcnt(0)" ::: "memory"); }
        __syncthreads();
        for (int rep = 0; rep < REP_HO; ++rep) if (PH(10)) hgrn_out(a, li, lds_raw);
        GSYNC();
        for (int hf = 0; hf < 2; ++hf) {
            for (int rep = 0; rep < REP_P3A; ++rep) if (PH(11)) { pg8::Gemm g{BUFH, WIN + (size_t)4096 * DM, DM, DM, DM, 0, 0}; pg8::StaticOrder S; S.init(MTOK / 2, 4096, G, bx, hf * (MTOK / 512));
              pg8::stage_rstd(SSA, S, lds_raw);
              pg8::EpiGate E{ZG, SSA, a.in[I_MB] + (size_t)li * 4096, lds_raw};
              pg8::gemm_phase(ldsl, g, S, E); }
            GSYNC();
            for (int rep = 0; rep < REP_P3B; ++rep) if (PH(12)) { pg8::Gemm g{BUFY, (const bf16_t*)(ws + WS_WUP) + (size_t)li * 4 * DM * BW, DM, BW, BW, (size_t)BW * 2, (size_t)DM * BW * 2}; pg8::SubOrder S; S.so.init(MTOK / 2, DM, G, bx, hf * (MTOK / 512));
              pg8::EpiMerge E{ZG, BUFH};
              pg8::gemm_phase(ldsl, g, S, E); }
        }
        GSYNC();
        if (PH(13)) { pg8::Gemm g{BUFH, (const bf16_t*)(ws + WS_WO) + (size_t)li * DM * DM, DM, DM, DM, 0, 0}; pg8::StaticOrder S; S.init(MTOK, DM, G, bx);
          pg8::EpiWo E{li == 0 ? a.in[I_X] : (const float*)a.out, a.out, BUFY, a.in[I_NPLE] + (size_t)li * DM, SSB};
          pg8::gemm_phase(ldsl, g, S, E); }
        if (PH(14)) { pg8::Gemm g{(const bf16_t*)(ws + WS_PBF), (const bf16_t*)(ws + WS_WPP) + (size_t)li * DM * PLE, PLE, PLE, PLE, 0, 0}; pg8::StaticOrder S; S.init(MTOK, DM, G, bx);
          pg8::EpiPlain E{ZG};
          pg8::gemm_phase(ldsl, g, S, E); }
        GSYNC();
        if (li + 1 < DEPTH) { const int t2 = opq(threadIdx.x), lane2 = t2 & 63, wave2 = t2 >> 6; float* scr2 = (float*)(lds_raw + wave2 * 16384);
            for (int it = bx * NWAVES + wave2; it < 4096; it += NGW) convert_win_item(a, li + 1, it, scr2, lane2); convert_p(a, li + 1); __syncthreads(); }
        if (PH(15)) { pg8::Gemm g{BUFY, (const bf16_t*)(ws + WS_WPG) + (size_t)li * DM * DM, DM, DM, DM, 0, 0}; pg8::StaticOrder S; S.init(MTOK, DM, G, bx);
          pg8::stage_rstd(SSB, S, lds_raw);
          pg8::EpiPle E{a.out, ZG, SSB, BUFH, a.in[I_NMIX] + (size_t)(li + 1 < DEPTH ? li + 1 : 0) * DM, SSA, li + 1 < DEPTH ? 1 : 0, lds_raw};
          pg8::gemm_phase(ldsl, g, S, E); }
        if (li + 1 < DEPTH) GSYNC();
    }
}

extern "C" void kernel_launch(void* const* d_in, const int* in_sizes, int n_in, void* d_out, int out_size, void* d_ws, size_t ws_size, hipStream_t stream) {
    static int grid = 0;
    if (grid == 0) {
        if (n_in != 20 || out_size != MTOK * DM || ws_size < WS_END) { fprintf(stderr, "kernel_launch: unexpected shapes (n_in %d, out %d, ws %zu)\n", n_in, out_size, ws_size); grid = -1; return; }
        int dev = 0, cus = 0, per_cu = 0;
        (void)hipGetDevice(&dev); (void)hipDeviceGetAttribute(&cus, hipDeviceAttributeMultiprocessorCount, dev);
        (void)hipFuncSetAttribute((const void*)mega_fwd, hipFuncAttributeMaxDynamicSharedMemorySize, LDS_BYTES);
        (void)hipOccupancyMaxActiveBlocksPerMultiprocessor(&per_cu, (const void*)mega_fwd, NTHR, LDS_BYTES);
        if (per_cu < 1) per_cu = 1;
        grid = cus * per_cu; if (grid > 256) grid = 256;
        if (grid != 256) { fprintf(stderr, "kernel_launch: this kernel needs a grid of exactly 256 co-resident workgroups (got %d); nothing launched\n", grid); grid = -1; return; }
        (void)hipGetLastError();
    }
    if (grid < 0) return;
    if (hipMemsetAsync(d_ws, 0, 65536, stream) != hipSuccess) { fprintf(stderr, "kernel_launch: memset failed\n"); return; }
    Args a{};
    for (int i = 0; i < 20; ++i) a.in[i] = (const float*)d_in[i];
    a.out = (float*)d_out; a.ws = (unsigned char*)d_ws;
    void* params[] = {&a};
    hipError_t e = hipLaunchCooperativeKernel((const void*)mega_fwd, dim3(grid), dim3(NTHR), params, LDS_BYTES, stream);
    if (e != hipSuccess) fprintf(stderr, "cooperative launch failed: %s (grid %d)\n", hipGetErrorString(e), grid);
}
```
